# Optimizing an MI355X kernel written in HIP

```python
import jax, jax.numpy as jnp
from jax import lax
import numpy as np

D_MODEL = 1024
BATCH = 8
SEQ = 2048
DEPTH = 4
DEC_BATCH = 128
DEC_SEQ = 8
PAST_LEN = 16384
PAGE_SIZE = 128

N_MIXERS = 2
N_A_LAYERS = (DEPTH + 1) // 2
N_B_LAYERS = DEPTH // 2
D_RNN = D_MODEL
RG_BLOCKS = 16
RG_BW = D_RNN // RG_BLOCKS
CONV_W = 4
RG_C = 8.0
GLA_HEADS = 4
GLA_DK = D_MODEL // 2
GLA_DV = D_MODEL
GLA_HK = GLA_DK // GLA_HEADS
GLA_HV = GLA_DV // GLA_HEADS
GLA_RANK = 16
GLA_TAU = 16.0
GLA_CHUNK = 64
GLA_IN = 2 * GLA_DK + 2 * GLA_DV + GLA_RANK
N_MEM = 256
XA_HEADS = 4
XA_HD = D_MODEL // XA_HEADS
D_FF = 4 * D_MODEL
EPS = 1e-6

kernel_name = "hybrid_rglru_gla_memxattn_step"


def rmsnorm(x, g):
    xf = x.astype(jnp.float32)
    y = xf * lax.rsqrt(jnp.mean(xf * xf, axis=-1, keepdims=True) + EPS)
    return (y * g.astype(jnp.float32)).astype(x.dtype)


def causal_dwconv(u, buf, w, b):
    T = u.shape[1]
    up = jnp.concatenate([buf.astype(u.dtype), u], axis=1)
    out = b + w[0] * up[:, 0:T]
    for j in range(1, CONV_W):
        out = out + w[j] * up[:, j:j + T]
    return out, up[:, -(CONV_W - 1):]


def rglru(u, h0, w_a, b_a, w_x, b_x, lam):
    B, T, _ = u.shape
    ub = u.reshape(B, T, RG_BLOCKS, RG_BW)
    r = jax.nn.sigmoid(jnp.einsum('bthi,hij->bthj', ub, w_a).reshape(B, T, D_RNN) + b_a)
    i = jax.nn.sigmoid(jnp.einsum('bthi,hij->bthj', ub, w_x).reshape(B, T, D_RNN) + b_x)
    log_a = -RG_C * r.astype(jnp.float32) * jax.nn.softplus(-lam.astype(jnp.float32))
    a = jnp.exp(log_a)
    mult = jnp.sqrt(-jnp.expm1(2.0 * log_a))
    bterm = mult * (i * u).astype(jnp.float32)
    bterm = bterm.at[:, 0].add(a[:, 0] * h0.astype(jnp.float32))

    def combine(left, right):
        a_l, b_l = left
        a_r, b_r = right
        return a_l * a_r, a_r * b_l + b_r

    _, h = lax.associative_scan(combine, (a, bterm), axis=1)
    return h.astype(u.dtype), h[:, -1].astype(h0.dtype)


def rg_block(xn, conv_buf, h0, w_in, conv_w, conv_b, w_a, b_a, w_x, b_x, lam, w_out):
    yx = xn @ w_in
    y_br, x_br = jnp.split(yx, [D_RNN], axis=-1)
    gate = jax.nn.gelu(y_br)
    xc, new_buf = causal_dwconv(x_br, conv_buf, conv_w, conv_b)
    h, h_last = rglru(xc, h0, w_a, b_a, w_x, b_x, lam)
    return (gate * h) @ w_out, new_buf.astype(conv_buf.dtype), h_last


def gla_chunked(q, k, v, log_a, S0, chunk):
    B, T, H, K = q.shape
    V = v.shape[-1]
    n = T // chunk

    def to_chunks(t):
        return jnp.moveaxis(t.reshape(B, n, chunk, H, t.shape[-1]), 1, 0)

    mask = jnp.tril(jnp.ones((chunk, chunk), dtype=bool))

    def step(S, inp):
        qc, kc, vc, lac = inp
        bcum = jnp.cumsum(lac, axis=1)
        g = bcum[:, -1]
        q_in = qc * jnp.exp(bcum)
        k_in = kc * jnp.exp(-bcum)
        att = jnp.where(mask, jnp.einsum('bthk,bshk->bhts', q_in, k_in), 0.0)
        o = jnp.einsum('bhts,bshv->bthv', att, vc) + jnp.einsum('bthk,bhkv->bthv', q_in, S)
        k_end = kc * jnp.exp(g[:, None] - bcum)
        S = jnp.exp(g)[..., None] * S + jnp.einsum('bshk,bshv->bhkv', k_end, vc)
        return S, o

    S, o = lax.scan(step, S0, (to_chunks(q), to_chunks(k), to_chunks(v), to_chunks(log_a)))
    o = jnp.moveaxis(o, 0, 1).reshape(B, T, H, V)
    return o, S


def gla_block(xn, S0, w_in, w_a2, b_a, norm_g, w_out):
    B, T, _ = xn.shape
    proj = xn @ w_in
    q, k, v, g, a_lo = jnp.split(
        proj, [GLA_DK, 2 * GLA_DK, 2 * GLA_DK + GLA_DV, 2 * GLA_DK + 2 * GLA_DV], axis=-1)
    q = q.reshape(B, T, GLA_HEADS, GLA_HK).astype(jnp.float32) * (GLA_HK ** -0.5)
    k = k.reshape(B, T, GLA_HEADS, GLA_HK).astype(jnp.float32)
    v = v.reshape(B, T, GLA_HEADS, GLA_HV).astype(jnp.float32)
    log_a = jax.nn.log_sigmoid((a_lo @ w_a2 + b_a).astype(jnp.float32)) / GLA_TAU
    log_a = log_a.reshape(B, T, GLA_HEADS, GLA_HK)
    chunk = GLA_CHUNK if T % GLA_CHUNK == 0 else T
    o, S = gla_chunked(q, k, v, log_a, S0.astype(jnp.float32), chunk)
    o = rmsnorm(o, norm_g).reshape(B, T, GLA_DV).astype(xn.dtype)
    return (o * jax.nn.silu(g)) @ w_out, S.astype(S0.dtype)


def mem_kv(mem, g, w_k, w_v):
    B, M, _ = mem.shape
    mn = rmsnorm(mem, g)
    return (mn @ w_k).reshape(B, M, XA_HEADS, XA_HD), (mn @ w_v).reshape(B, M, XA_HEADS, XA_HD)


def cross_attn(xn, k, v, w_q, w_o):
    B, T, _ = xn.shape
    q = (xn @ w_q).reshape(B, T, XA_HEADS, XA_HD)
    s = jnp.einsum('bthd,bmhd->bhtm', q, k.astype(q.dtype)).astype(jnp.float32) * (XA_HD ** -0.5)
    p = jax.nn.softmax(s, axis=-1).astype(xn.dtype)
    o = jnp.einsum('bhtm,bmhd->bthd', p, v.astype(xn.dtype)).reshape(B, T, D_MODEL)
    return o @ w_o


def run_group(x, mem_k, mem_v, rg_h, rg_conv, gla_S,
              norm_mix_g, norm_xa_g, norm_mlp_g, final_norm_g,
              rg_w_in, rg_conv_w, rg_conv_b, rg_w_a, rg_b_a, rg_w_x, rg_b_x, rg_lambda, rg_w_out,
              gla_w_in, gla_w_a2, gla_b_a, gla_norm_g, gla_w_out,
              xa_wq, xa_wo, mlp_w1, mlp_w2):
    hs, convs, Ss = [], [], []
    for layer in range(DEPTH):
        j = layer // N_MIXERS
        xn = rmsnorm(x, norm_mix_g[layer])
        if layer % N_MIXERS == 0:
            out, cb, hl = rg_block(xn, rg_conv[j], rg_h[j], rg_w_in[j], rg_conv_w[j], rg_conv_b[j],
                                   rg_w_a[j], rg_b_a[j], rg_w_x[j], rg_b_x[j], rg_lambda[j], rg_w_out[j])
            convs.append(cb)
            hs.append(hl)
        else:
            out, S = gla_block(xn, gla_S[j], gla_w_in[j], gla_w_a2[j], gla_b_a[j], gla_norm_g[j], gla_w_out[j])
            Ss.append(S)
        x = x + out
        x = x + cross_attn(rmsnorm(x, norm_xa_g[layer]), mem_k[layer], mem_v[layer], xa_wq[layer], xa_wo[layer])
        hid = rmsnorm(x, norm_mlp_g[layer]) @ mlp_w1[layer]
        x = x + jnp.square(jax.nn.relu(hid)) @ mlp_w2[layer]
    y = rmsnorm(x, final_norm_g)
    return y, jnp.stack(hs), jnp.stack(convs), jnp.stack(Ss)


def setup_inputs(seed: int = 0) -> dict:
    key = jax.random.key(seed)
    ks = iter(jax.random.split(key, 48))

    def nrm(shape, s):
        return jax.random.normal(next(ks), shape, jnp.float32) * s

    d = D_MODEL
    u = jax.random.uniform(next(ks), (N_A_LAYERS, D_RNN), jnp.float32, minval=0.9, maxval=0.999)
    return {
        "x_prompt": nrm((BATCH, SEQ, d), 1.0),
        "x_sample": nrm((DEC_BATCH, DEC_SEQ, d), 1.0),
        "mem_prompt": nrm((BATCH, N_MEM, d), 1.0),
        "state_rglru_h": nrm((N_A_LAYERS, DEC_BATCH, D_RNN), 0.5),
        "state_rglru_conv": nrm((N_A_LAYERS, DEC_BATCH, CONV_W - 1, D_RNN), 1.0),
        "state_gla_S": nrm((N_B_LAYERS, DEC_BATCH, GLA_HEADS, GLA_HK, GLA_HV), 1.0),
        "cache_mem_k": nrm((DEPTH, DEC_BATCH, N_MEM, XA_HEADS, XA_HD), 1.0),
        "cache_mem_v": nrm((DEPTH, DEC_BATCH, N_MEM, XA_HEADS, XA_HD), 1.0),
        "norm_mix_g": 1.0 + nrm((DEPTH, d), 0.01),
        "norm_xa_g": 1.0 + nrm((DEPTH, d), 0.01),
        "norm_mem_g": 1.0 + nrm((DEPTH, d), 0.01),
        "norm_mlp_g": 1.0 + nrm((DEPTH, d), 0.01),
        "final_norm_g": 1.0 + nrm((d,), 0.01),
        "rg_w_in": nrm((N_A_LAYERS, d, 2 * D_RNN), d ** -0.5),
        "rg_conv_w": nrm((N_A_LAYERS, CONV_W, D_RNN), CONV_W ** -0.5),
        "rg_conv_b": nrm((N_A_LAYERS, D_RNN), 0.01),
        "rg_w_a": nrm((N_A_LAYERS, RG_BLOCKS, RG_BW, RG_BW), RG_BW ** -0.5),
        "rg_b_a": nrm((N_A_LAYERS, D_RNN), 0.01),
        "rg_w_x": nrm((N_A_LAYERS, RG_BLOCKS, RG_BW, RG_BW), RG_BW ** -0.5),
        "rg_b_x": nrm((N_A_LAYERS, D_RNN), 0.01),
        "rg_lambda": jnp.log(u) - jnp.log1p(-u),
        "rg_w_out": nrm((N_A_LAYERS, D_RNN, d), D_RNN ** -0.5),
        "gla_w_in": nrm((N_B_LAYERS, d, GLA_IN), d ** -0.5),
        "gla_w_a2": nrm((N_B_LAYERS, GLA_RANK, GLA_DK), GLA_RANK ** -0.5),
        "gla_b_a": nrm((N_B_LAYERS, GLA_DK), 0.01),
        "gla_norm_g": 1.0 + nrm((N_B_LAYERS, GLA_HV), 0.01),
        "gla_w_out": nrm((N_B_LAYERS, GLA_DV, d), GLA_DV ** -0.5),
        "xa_wq": nrm((DEPTH, d, d), d ** -0.5),
        "xa_wk": nrm((DEPTH, d, d), d ** -0.5),
        "xa_wv": nrm((DEPTH, d, d), d ** -0.5),
        "xa_wo": nrm((DEPTH, d, d), d ** -0.5),
        "mlp_w1": nrm((DEPTH, d, D_FF), d ** -0.5),
        "mlp_w2": nrm((DEPTH, D_FF, d), D_FF ** -0.5),
    }


def reference(x_prompt, x_sample, mem_prompt, state_rglru_h, state_rglru_conv, state_gla_S,
              cache_mem_k, cache_mem_v,
              norm_mix_g, norm_xa_g, norm_mem_g, norm_mlp_g, final_norm_g,
              rg_w_in, rg_conv_w, rg_conv_b, rg_w_a, rg_b_a, rg_w_x, rg_b_x, rg_lambda, rg_w_out,
              gla_w_in, gla_w_a2, gla_b_a, gla_norm_g, gla_w_out,
              xa_wq, xa_wk, xa_wv, xa_wo, mlp_w1, mlp_w2):
    weights = (norm_mix_g, norm_xa_g, norm_mlp_g, final_norm_g,
               rg_w_in, rg_conv_w, rg_conv_b, rg_w_a, rg_b_a, rg_w_x, rg_b_x, rg_lambda, rg_w_out,
               gla_w_in, gla_w_a2, gla_b_a, gla_norm_g, gla_w_out,
               xa_wq, xa_wo, mlp_w1, mlp_w2)

    kv = [mem_kv(mem_prompt, norm_mem_g[l], xa_wk[l], xa_wv[l]) for l in range(DEPTH)]
    mem_k_prompt = jnp.stack([kv_l[0] for kv_l in kv])
    mem_v_prompt = jnp.stack([kv_l[1] for kv_l in kv])
    dt = x_prompt.dtype
    h0_p = jnp.zeros((N_A_LAYERS, BATCH, D_RNN), dt)
    conv0_p = jnp.zeros((N_A_LAYERS, BATCH, CONV_W - 1, D_RNN), dt)
    S0_p = jnp.zeros((N_B_LAYERS, BATCH, GLA_HEADS, GLA_HK, GLA_HV), dt)
    y_prompt, rglru_h_prompt, rglru_conv_prompt, gla_S_prompt = run_group(
        x_prompt, mem_k_prompt, mem_v_prompt, h0_p, conv0_p, S0_p, *weights)

    y_sample, rglru_h_sample, rglru_conv_sample, gla_S_sample = run_group(
        x_sample, cache_mem_k, cache_mem_v, state_rglru_h, state_rglru_conv, state_gla_S, *weights)

    return (y_prompt, y_sample, mem_k_prompt, mem_v_prompt, rglru_h_prompt, rglru_conv_prompt,
            gla_S_prompt, rglru_h_sample, rglru_conv_sample, gla_S_sample)
```

```cpp
#include <hip/hip_runtime.h>
#include <cstdio>
#include <cstdint>

#define DI __device__ __forceinline__
#define GAS __attribute__((address_space(1)))
#define LAS __attribute__((address_space(3)))
typedef unsigned short bf16;
typedef short bf16x8 __attribute__((ext_vector_type(8)));
typedef short s16x4 __attribute__((ext_vector_type(4)));
typedef float f32x2 __attribute__((ext_vector_type(2)));
typedef float f32x4 __attribute__((ext_vector_type(4)));
typedef float f32x16 __attribute__((ext_vector_type(16)));
typedef unsigned u32x2 __attribute__((ext_vector_type(2)));
typedef unsigned u32x4 __attribute__((ext_vector_type(4)));
typedef __bf16 bf2_t __attribute__((ext_vector_type(2)));

DI unsigned pk2(float lo, float hi) { f32x2 v = {lo, hi}; return __builtin_bit_cast(unsigned, __builtin_convertvector(v, bf2_t)); }
DI float bf_lo(unsigned u) { return __uint_as_float(u << 16); }
DI float bf_hi(unsigned u) { return __uint_as_float(u & 0xffff0000u); }
DI float bf2f(bf16 b) { return __uint_as_float(((unsigned)b) << 16); }
DI bf16 f2bf(float f) { return (bf16)(pk2(f, 0.f) & 0xffffu); }
DI float fexp(float x) { return __builtin_amdgcn_exp2f(x * 1.4426950408889634f); }
DI float frcp(float x) { return __builtin_amdgcn_rcpf(x); }
DI float fsigmoid(float x) { return frcp(1.0f + fexp(-x)); }
typedef unsigned u32x2p __attribute__((ext_vector_type(2)));
DI float xsum16(float v) { const unsigned u = __float_as_uint(v); const u32x2p r = __builtin_amdgcn_permlane16_swap(u, u, false, false); return __uint_as_float(r[0]) + __uint_as_float(r[1]); }
DI float xsum32(float v) { const unsigned u = __float_as_uint(v); const u32x2p r = __builtin_amdgcn_permlane32_swap(u, u, false, false); return __uint_as_float(r[0]) + __uint_as_float(r[1]); }
DI float xmax32(float v) { const unsigned u = __float_as_uint(v); const u32x2p r = __builtin_amdgcn_permlane32_swap(u, u, false, false); return fmaxf(__uint_as_float(r[0]), __uint_as_float(r[1])); }
DI void halves32(float v, float& lo, float& hi) { const unsigned u = __float_as_uint(v); const u32x2p r = __builtin_amdgcn_permlane32_swap(u, u, false, false); lo = __uint_as_float(r[0]); hi = __uint_as_float(r[1]); }
DI float xsum_row16(float v) {
    v += __uint_as_float(__builtin_amdgcn_mov_dpp(__float_as_uint(v), 0xB1, 0xF, 0xF, true));
    v += __uint_as_float(__builtin_amdgcn_mov_dpp(__float_as_uint(v), 0x4E, 0xF, 0xF, true));
    v += __uint_as_float(__builtin_amdgcn_mov_dpp(__float_as_uint(v), 0x141, 0xF, 0xF, true));
    v += __uint_as_float(__builtin_amdgcn_mov_dpp(__float_as_uint(v), 0x140, 0xF, 0xF, true));
    return v;
}
DI float wave_sum(float v) { return xsum32(xsum16(xsum_row16(v))); }
#define LDS_WAIT() asm volatile("s_waitcnt lgkmcnt(0)" ::: "memory")
#define VM_WAIT() asm volatile("s_waitcnt vmcnt(0)" ::: "memory")

namespace pg8 {
#define PG8_LAS __attribute__((address_space(3)))
typedef unsigned short bf16_t;
typedef short bf16x8 __attribute__((ext_vector_type(8)));
typedef float f32x4 __attribute__((ext_vector_type(4)));
typedef unsigned u32x4 __attribute__((ext_vector_type(4)));
constexpr int BM = 256, BK = 64, HALF = 128, HTB = HALF * BK * 2  , STAGE_BYTES = 8 * HTB, NXCD = 8, WGM = 8;

__host__ __device__ __forceinline__ int lds_byte(int r, int c) { const int st = (r >> 4) * 2 + (c >> 5), rr = r & 15, cc = c & 31, ob = rr * 64 + cc * 2; return st * 1024 + (ob ^ (((ob >> 9) & 1) << 5)); }
__host__ __device__ __forceinline__ void stage_rc(int b, int& R, int& C) { const int st = b / 1024, sb = b % 1024, swz = sb ^ (((sb >> 9) & 1) << 5); R = (st >> 1) * 16 + swz / 64; C = (st & 1) * 32 + (swz % 64) / 2; }
__host__ __device__ __forceinline__ int perm32(int rho) { const int n = rho >> 4, i = rho & 15; return 8 * (i >> 2) + 4 * n + (i & 3); }

struct Unit { int pm, pn; };
struct Gemm { const bf16_t* A; const bf16_t* Bt; int M, N, K; };

struct StaticOrder {
    int nM, nN, nwg, G, c;
    __host__ __device__ void init(int M, int N, int G_, int c_) { nM = M / BM; nN = N / BM; nwg = nM * nN; G = G_; c = c_; }
    __host__ __device__ bool next(int i, Unit& u) const {
        const long L = (long)i * G + c; if (L >= nwg) return false;
        int wgid = (int)L; { const int q = nwg / NXCD, r = nwg % NXCD, xcd = wgid % NXCD, off = wgid / NXCD; wgid = (xcd < r ? xcd * (q + 1) : r * (q + 1) + (xcd - r) * q) + off; }
        const int nig = WGM * nN, gid = wgid / nig, fm = gid * WGM, gsz = (nM - fm) < WGM ? (nM - fm) : WGM;
        u.pm = fm + ((wgid % nig) % gsz); u.pn = (wgid % nig) / gsz; return true;
    }
    __device__ __forceinline__ void a_ready(const Unit&) const {}
    __device__ __forceinline__ void done(const Unit&) const {}
};

constexpr float RMS_EPS = 1e-6f;
DI float rs_of_row(const float* SS, int row, int fq) {
    const f32x4 a = *(const f32x4*)(SS + (size_t)row * 32 + 8 * fq), b = *(const f32x4*)(SS + (size_t)row * 32 + 8 * fq + 4);
    float s = ((a[0] + a[1]) + (a[2] + a[3])) + ((b[0] + b[1]) + (b[2] + b[3]));
    s = xsum32(xsum16(s));
    return __builtin_amdgcn_rsqf(s * (1.0f / 1024.0f) + RMS_EPS);
}
DI u32x4 pack8(const f32x4 v0, const f32x4 v1) { u32x4 w; w.x = pk2(v0[0], v0[1]); w.y = pk2(v0[2], v0[3]); w.z = pk2(v1[0], v1[1]); w.w = pk2(v1[2], v1[3]); return w; }
DI float gelu_tanh(float x) { const float u = 0.7978845608028654f * (x + 0.044715f * x * x * x); return x * frcp(1.0f + fexp(-2.0f * u)); }
DI float silu_f(float x) { return x * frcp(1.0f + fexp(-x)); }

struct XupdR8 {
    static constexpr bool NEED_RS = false, HAS_PRE = true;
    bf16_t* XB; float* SS; float scale;
    DI u32x4 pre(int row, int col) const { return *(const u32x4*)(XB + (size_t)row * 1024 + col); }
    DI void row8p(int row, int col, f32x4 v0, f32x4 v1, const u32x4 w, int fq) const {
        f32x4 x0 = (f32x4){bf_lo(w.x), bf_hi(w.x), bf_lo(w.y), bf_hi(w.y)}, x1 = (f32x4){bf_lo(w.z), bf_hi(w.z), bf_lo(w.w), bf_hi(w.w)};
        x0 = x0 + v0 * scale; x1 = x1 + v1 * scale;
        *(u32x4*)(XB + (size_t)row * 1024 + col) = pack8(x0, x1);
        float s = ((x0[0] * x0[0] + x0[1] * x0[1]) + (x0[2] * x0[2] + x0[3] * x0[3])) + ((x1[0] * x1[0] + x1[1] * x1[1]) + (x1[2] * x1[2] + x1[3] * x1[3]));
        s = xsum32(xsum16(s));
        if (fq == 0) SS[(size_t)row * 32 + (col >> 5)] = s;
    }
    DI void row8(int row, int col, f32x4 v0, f32x4 v1, float, int fq) const { row8p(row, col, v0, v1, pre(row, col), fq); }
    DI void row8i(int row, int col, f32x4 x0, f32x4 x1, int fq) const {
        *(u32x4*)(XB + (size_t)row * 1024 + col) = pack8(x0, x1);
        float s = ((x0[0] * x0[0] + x0[1] * x0[1]) + (x0[2] * x0[2] + x0[3] * x0[3])) + ((x1[0] * x1[0] + x1[1] * x1[1]) + (x1[2] * x1[2] + x1[3] * x1[3]));
        s = xsum32(xsum16(s));
        if (fq == 0) SS[(size_t)row * 32 + (col >> 5)] = s;
    }
};
template <int MODE> struct RsBf16R8 {
    static constexpr bool NEED_RS = true, HAS_PRE = false;
    bf16_t* O; int ldc; const float* SS; const PG8_LAS float* rsl;
    DI void row8(int row, int col, f32x4 v0, f32x4 v1, float r, int) const {
        v0 = v0 * r; v1 = v1 * r;
        if (MODE == 1) {
#pragma unroll
            for (int j = 0; j < 4; ++j) { const float a = v0[j] > 0.f ? v0[j] : 0.f, b = v1[j] > 0.f ? v1[j] : 0.f; v0[j] = a * a; v1[j] = b * b; } }
        *(u32x4*)(O + (size_t)row * ldc + col) = pack8(v0, v1);
    }
};
struct RgInR8 {
    static constexpr bool NEED_RS = true, HAS_PRE = false;
    bf16_t* GATE; bf16_t* XBR; const float* SS; float* convP; float* convS; const PG8_LAS float* rsl;
    DI void row8(int row, int col, f32x4 v0, f32x4 v1, float r, int) const {
        v0 = v0 * r; v1 = v1 * r;
        if (col < 1024) {
#pragma unroll
            for (int j = 0; j < 4; ++j) { v0[j] = gelu_tanh(v0[j]); v1[j] = gelu_tanh(v1[j]); }
            *(u32x4*)(GATE + (size_t)row * 1024 + col) = pack8(v0, v1);
        } else {
            const int c = col - 1024; float* tail = nullptr;
            if (row < 16384) { const int t = row & 2047; if (t >= 2045) tail = convP + ((size_t)(row >> 11) * 3 + (t - 2045)) * 1024 + c; }
            else { const int rr = row - 16384, t = rr & 7; if (t >= 5) tail = convS + ((size_t)(rr >> 3) * 3 + (t - 5)) * 1024 + c; }
            if (tail) { *(f32x4*)tail = v0; *(f32x4*)(tail + 4) = v1; }
            *(u32x4*)(XBR + (size_t)row * 1024 + c) = pack8(v0, v1);
        }
    }
};
struct GlaInR8 {
    static constexpr bool NEED_RS = true, HAS_PRE = false;
    bf16_t* QKVG; const float* SS; const PG8_LAS float* rsl;
    DI void row8(int row, int col, f32x4 v0, f32x4 v1, float r, int) const {
        v0 = v0 * r; v1 = v1 * r;
        if (col >= 2048) {
#pragma unroll
            for (int j = 0; j < 4; ++j) { v0[j] = silu_f(v0[j]); v1[j] = silu_f(v1[j]); } }
        *(u32x4*)(QKVG + (size_t)row * 3072 + col) = pack8(v0, v1);
    }
};
struct MemKVR8 {
    static constexpr bool NEED_RS = false, HAS_PRE = false;
    float* outK; float* outV; bf16_t* KPB; bf16_t* VPB; const float* SS;
    DI void row8(int row, int col, f32x4 v0, f32x4 v1, float, int) const {
        const int l = col >> 11, kv = (col >> 10) & 1, c = col & 1023;
        const size_t off = (size_t)l * 2048 * 1024 + (size_t)row * 1024 + c;
        float* of = (kv ? outV : outK) + off; __builtin_nontemporal_store(v0, (f32x4*)of); __builtin_nontemporal_store(v1, (f32x4*)(of + 4));
        *(u32x4*)((kv ? VPB : KPB) + off) = pack8(v0, v1);
    }
};
struct GroupOrder {
    int ppg, nN, grp, rank; bool rev = false;
    DI bool next(int i, Unit& u) const { const int L = i * 32 + rank; if (L >= ppg * nN) return false; u.pm = ppg * grp + (L % ppg); u.pn = rev ? nN - 1 - L / ppg : L / ppg; return true; }
    DI void a_ready(const Unit&) const {}
    DI void done(const Unit&) const {}
};
template <class R8, int TAG = 0> struct BigEpi {
    static constexpr bool PERM = true, AFTER_DRAIN = false, HAS_INIT = R8::HAS_PRE;
    R8 e;
    DI void init_issue(u32x4 (&w)[R8::HAS_PRE ? 16 : 1], const Unit& u, int wr, int wc, int fr, int fq) const {
        if constexpr (R8::HAS_PRE) {
            const int row0 = u.pm * BM + wr * 64 + fr, col0 = u.pn * BM + wc * 32 + 8 * fq;
#pragma unroll
            for (int ai = 0; ai < 2; ++ai)
#pragma unroll
                for (int m = 0; m < 4; ++m)
#pragma unroll
                    for (int bj = 0; bj < 2; ++bj) w[(ai * 4 + m) * 2 + bj] = e.pre(row0 + ai * HALF + m * 16, col0 + bj * HALF);
        }
    }
    DI void init_finish(f32x4 (&acc)[2][2][4][2], const u32x4 (&w)[R8::HAS_PRE ? 16 : 1]) const {
        if constexpr (R8::HAS_PRE) {
#pragma unroll
            for (int ai = 0; ai < 2; ++ai)
#pragma unroll
                for (int m = 0; m < 4; ++m)
#pragma unroll
                    for (int bj = 0; bj < 2; ++bj) { const u32x4 v = w[(ai * 4 + m) * 2 + bj];
                        acc[ai][bj][m][0] = (f32x4){bf_lo(v.x), bf_hi(v.x), bf_lo(v.y), bf_hi(v.y)}; acc[ai][bj][m][1] = (f32x4){bf_lo(v.z), bf_hi(v.z), bf_lo(v.w), bf_hi(v.w)}; }
        }
    }
    DI void init(f32x4 (&acc)[2][2][4][2], const Unit& u, int wr, int wc, int fr, int fq) const { u32x4 w[R8::HAS_PRE ? 16 : 1]; init_issue(w, u, wr, wc, fr, fq); init_finish(acc, w); }
    DI void operator()(const f32x4 (&acc)[2][2][4][2], const Unit& u, int wr, int wc, int fr, int fq) const {
        const int row0 = u.pm * BM + wr * 64 + fr, col0 = u.pn * BM + wc * 32 + 8 * fq;
        if constexpr (R8::HAS_PRE) {
#pragma unroll
            for (int ai = 0; ai < 2; ++ai)
#pragma unroll
                for (int m = 0; m < 4; ++m)
#pragma unroll
                    for (int bj = 0; bj < 2; ++bj) e.row8i(row0 + ai * HALF + m * 16, col0 + bj * HALF, acc[ai][bj][m][0], acc[ai][bj][m][1], fq);
        } else {
            float rs[2][4];
#pragma unroll
            for (int ai = 0; ai < 2; ++ai)
#pragma unroll
                for (int m = 0; m < 4; ++m) { if constexpr (R8::NEED_RS) rs[ai][m] = e.rsl[wr * 64 + fr + ai * HALF + m * 16]; else rs[ai][m] = 1.f; }
#pragma unroll
            for (int ai = 0; ai < 2; ++ai)
#pragma unroll
                for (int m = 0; m < 4; ++m) {
#pragma unroll
                    for (int bj = 0; bj < 2; ++bj) e.row8(row0 + ai * HALF + m * 16, col0 + bj * HALF, acc[ai][bj][m][0], acc[ai][bj][m][1], rs[ai][m], fq);
                }
        }
    }
};

template <class Epi, class Sched, bool ALIGN_EPI = false, bool SP2 = false>
__device__ __forceinline__ void gemm_phase(PG8_LAS unsigned char* lds, const Gemm g, const Sched& S, const Epi& E, const int tid) {
    const int wid = __builtin_amdgcn_readfirstlane(tid >> 6), lane = tid & 63, wr = wid >> 2, wc = wid & 3, fr = lane & 15, fq = lane >> 4;
    const int K = g.K, nt = K / BK;
    unsigned voffA[2], voffB[2];
#pragma unroll
    for (int i = 0; i < 2; ++i) { int R, C; stage_rc(tid * 16 + i * 8192, R, C); const int Rb = Epi::PERM ? ((R & ~31) + perm32(R & 31)) : R;
        voffA[i] = (unsigned)(R * K + C) * 2u; voffB[i] = (unsigned)(Rb * K + C) * 2u; }
    const size_t kstep = (size_t)(BK * 2);
    const size_t hstep = (size_t)HALF * K * 2;
    const size_t tstep = 2 * hstep;
    const unsigned ldsw = (unsigned)wid * 1024u;
    const int aoff = lds_byte(wr * 64 + fr, fq * 8), boff = lds_byte(wc * 32 + fr, fq * 8);
#define PG8_SA(b, h) (((b) * 2 + (h)) * HTB)
#define PG8_SB(b, h) ((4 + (b) * 2 + (h)) * HTB)
#define PG8_STAGE(bufoff, gbase, voff) do { _Pragma("unroll") for (int _i = 0; _i < 2; ++_i) \
        __builtin_amdgcn_global_load_lds((const unsigned*)((const char*)(gbase) + (voff)[_i]), (PG8_LAS unsigned*)(lds + (bufoff) + ldsw + _i * 8192), 16, 0, 0); } while (0)
#define PG8_LDA(dst, b, h) do { _Pragma("unroll") for (int m = 0; m < 4; ++m) _Pragma("unroll") for (int k = 0; k < 2; ++k) dst[m][k] = *(const PG8_LAS bf16x8*)(lds + PG8_SA(b, h) + aoff + m * 2048 + k * 1024); } while (0)
#define PG8_LDB(dst, b, h) do { _Pragma("unroll") for (int n = 0; n < 2; ++n) _Pragma("unroll") for (int k = 0; k < 2; ++k) dst[n][k] = *(const PG8_LAS bf16x8*)(lds + PG8_SB(b, h) + boff + n * 2048 + k * 1024); } while (0)
#define PG8_MMA(ai, bj, At, Bt) do { __builtin_amdgcn_s_setprio(1); _Pragma("unroll") for (int m = 0; m < 4; ++m) _Pragma("unroll") for (int n = 0; n < 2; ++n) _Pragma("unroll") for (int k = 0; k < 2; ++k) \
        acc[ai][bj][m][n] = __builtin_amdgcn_mfma_f32_16x16x32_bf16(Bt[n][k], At[m][k], acc[ai][bj][m][n], 0, 0, 0); __builtin_amdgcn_s_setprio(0); } while (0)
#define PG8_WAIT_V(n) asm volatile("s_waitcnt vmcnt(" #n ")" ::: "memory")
#define PG8_WAIT_L(n) asm volatile("s_waitcnt lgkmcnt(" #n ")" ::: "memory")
#define PG8_BAR __builtin_amdgcn_s_barrier()
#define PG8_SCHED __builtin_amdgcn_sched_barrier(0)
    Unit cur, nxt; int ui = 0;
    if (!S.next(0, cur)) return;
    f32x4 acc[2][2][4][2];
    u32x4 iw_[Epi::HAS_INIT ? 16 : 1];
    if constexpr (Epi::HAS_INIT) E.init_issue(iw_, cur, wr, wc, fr, fq);
    else {
#pragma unroll
    for (int a = 0; a < 2; ++a)
#pragma unroll
        for (int b = 0; b < 2; ++b)
#pragma unroll
            for (int m = 0; m < 4; ++m)
#pragma unroll
                for (int n = 0; n < 2; ++n) acc[a][b][m][n] = (f32x4){0.f, 0.f, 0.f, 0.f};
    }
    bf16x8 At[4][2], B0[2][2], B1[2][2];
    const char* cA = (const char*)g.A + (size_t)cur.pm * tstep; const char* cB = (const char*)g.Bt + (size_t)cur.pn * tstep;
    S.a_ready(cur);
    if constexpr (SP2) {
        PG8_STAGE(PG8_SB(0, 0), cB, voffB); PG8_STAGE(PG8_SB(0, 1), cB + hstep, voffB); PG8_STAGE(PG8_SA(0, 0), cA, voffA); PG8_STAGE(PG8_SA(0, 1), cA + hstep, voffA);
        if (wr == 1) PG8_BAR;
        PG8_WAIT_V(2); PG8_BAR;
        PG8_STAGE(PG8_SB(1, 0), cB + kstep, voffB); PG8_STAGE(PG8_SA(1, 0), cA + kstep, voffA); PG8_STAGE(PG8_SB(1, 1), cB + hstep + kstep, voffB);
        PG8_WAIT_V(6); PG8_BAR;
    } else {
        PG8_STAGE(PG8_SB(0, 0), cB, voffB); PG8_STAGE(PG8_SA(0, 0), cA, voffA); PG8_STAGE(PG8_SB(0, 1), cB + hstep, voffB); PG8_STAGE(PG8_SA(0, 1), cA + hstep, voffA);
        if (wr == 1) PG8_BAR;
        PG8_WAIT_V(4); PG8_BAR;
        PG8_STAGE(PG8_SB(1, 0), cB + kstep, voffB); PG8_STAGE(PG8_SA(1, 0), cA + kstep, voffA); PG8_STAGE(PG8_SB(1, 1), cB + hstep + kstep, voffB);
        PG8_WAIT_V(6); PG8_BAR;
    }
    if constexpr (Epi::HAS_INIT) E.init_finish(acc, iw_);
    for (;;) {
        const bool has_next = S.next(ui + 1, nxt);
        const char* nA = has_next ? (const char*)g.A + (size_t)nxt.pm * tstep : cA; const char* nB = has_next ? (const char*)g.Bt + (size_t)nxt.pn * tstep : cB;
        for (int t = 0; t < nt; t += 2) {
            const bool last = (t == nt - 2);
            const char* a1 = cA + (size_t)(t + 1) * kstep;
            const char* a2 = last ? nA : cA + (size_t)(t + 2) * kstep; const char* b2 = last ? nB : cB + (size_t)(t + 2) * kstep;
            const char* a3 = a2 + kstep; const char* b3 = b2 + kstep;
            if (last && has_next) S.a_ready(nxt);
            if constexpr (SP2) {
            PG8_LDB(B0, 0, 0); PG8_LDB(B1, 0, 1); PG8_SCHED; PG8_LDA(At, 0, 0); PG8_STAGE(PG8_SA(1, 1), a1 + hstep, voffA);
            PG8_WAIT_V(8); PG8_WAIT_L(0); PG8_BAR; PG8_MMA(0, 0, At, B0); PG8_MMA(0, 1, At, B1); PG8_BAR; PG8_SCHED;
            PG8_LDA(At, 0, 1); PG8_STAGE(PG8_SB(0, 0), b2, voffB); PG8_STAGE(PG8_SB(0, 1), b2 + hstep, voffB); PG8_STAGE(PG8_SA(0, 0), a2, voffA);
            PG8_WAIT_V(8); PG8_WAIT_L(0); PG8_BAR; PG8_MMA(1, 0, At, B0); PG8_MMA(1, 1, At, B1); PG8_BAR; PG8_SCHED;
            PG8_LDB(B0, 1, 0); PG8_LDB(B1, 1, 1); PG8_SCHED; PG8_LDA(At, 1, 0); PG8_STAGE(PG8_SA(0, 1), a2 + hstep, voffA);
            PG8_WAIT_V(8); PG8_WAIT_L(0); PG8_BAR; PG8_MMA(0, 0, At, B0); PG8_MMA(0, 1, At, B1); PG8_BAR; PG8_SCHED;
            PG8_LDA(At, 1, 1); PG8_STAGE(PG8_SB(1, 0), b3, voffB); PG8_STAGE(PG8_SB(1, 1), b3 + hstep, voffB); PG8_STAGE(PG8_SA(1, 0), a3, voffA);
            PG8_WAIT_V(8); PG8_WAIT_L(0); PG8_BAR; PG8_MMA(1, 0, At, B0); PG8_MMA(1, 1, At, B1); PG8_BAR; PG8_SCHED;
            } else {
            PG8_LDB(B0, 0, 0); PG8_SCHED; PG8_LDA(At, 0, 0); PG8_STAGE(PG8_SA(1, 1), a1 + hstep, voffA);
            PG8_WAIT_L(8); PG8_BAR; PG8_WAIT_L(0); PG8_MMA(0, 0, At, B0); PG8_BAR; PG8_SCHED;
            PG8_LDB(B1, 0, 1); PG8_STAGE(PG8_SB(0, 0), b2, voffB);
            PG8_BAR; PG8_WAIT_L(0); PG8_MMA(0, 1, At, B1); PG8_BAR;
            PG8_LDA(At, 0, 1); PG8_STAGE(PG8_SA(0, 0), a2, voffA);
            PG8_BAR; PG8_WAIT_L(0); PG8_MMA(1, 0, At, B0); PG8_BAR; PG8_SCHED;
            PG8_STAGE(PG8_SB(0, 1), b2 + hstep, voffB);
            PG8_WAIT_V(6); PG8_BAR; PG8_MMA(1, 1, At, B1); PG8_BAR;
            PG8_LDB(B0, 1, 0); PG8_SCHED; PG8_LDA(At, 1, 0); PG8_STAGE(PG8_SA(0, 1), a2 + hstep, voffA);
            PG8_WAIT_L(8); PG8_BAR; PG8_WAIT_L(0); PG8_MMA(0, 0, At, B0); PG8_BAR; PG8_SCHED;
            PG8_LDB(B1, 1, 1); PG8_STAGE(PG8_SB(1, 0), b3, voffB);
            PG8_BAR; PG8_WAIT_L(0); PG8_MMA(0, 1, At, B1); PG8_BAR;
            PG8_LDA(At, 1, 1); PG8_STAGE(PG8_SA(1, 0), a3, voffA);
            PG8_BAR; PG8_WAIT_L(0); PG8_MMA(1, 0, At, B0); PG8_BAR; PG8_SCHED;
            PG8_STAGE(PG8_SB(1, 1), b3 + hstep, voffB);
            PG8_WAIT_V(6); PG8_BAR; PG8_MMA(1, 1, At, B1); PG8_BAR;
            }
        }
        if constexpr (ALIGN_EPI) { if (wr == 0) PG8_BAR; }
        if constexpr (!Epi::AFTER_DRAIN) { E(acc, cur, wr, wc, fr, fq); S.done(cur); }
        if (!has_next) break;
        if constexpr (Epi::HAS_INIT) E.init(acc, nxt, wr, wc, fr, fq);
        else {
#pragma unroll
        for (int a = 0; a < 2; ++a)
#pragma unroll
            for (int b = 0; b < 2; ++b)
#pragma unroll
                for (int m = 0; m < 4; ++m)
#pragma unroll
                    for (int n = 0; n < 2; ++n) acc[a][b][m][n] = (f32x4){0.f, 0.f, 0.f, 0.f};
        }
        cur = nxt; cA = nA; cB = nB; ++ui;
        if constexpr (ALIGN_EPI) { if (wr == 1) PG8_BAR; }
    }
    PG8_WAIT_V(0);
    if constexpr (!ALIGN_EPI) { if (wr == 0) PG8_BAR; }
    PG8_BAR;
    if constexpr (Epi::AFTER_DRAIN) { E.fused(acc, cur, wr, wc, fr, fq, lds, wid, lane); S.done(cur); }
#undef PG8_SA
#undef PG8_SB
#undef PG8_STAGE
#undef PG8_LDA
#undef PG8_LDB
#undef PG8_MMA
#undef PG8_WAIT_V
#undef PG8_WAIT_L
#undef PG8_BAR
#undef PG8_SCHED
}
}
#define XB_TMO      128
#define XB_XCNT(j)  (256  + 64 * (j))
#define XB_XSUB(j)  (1280 + 64 * (j))
#define XB_XGEN(j)  (2304 + 64 * (j))
#define XB_TOP      3328
#define XB_TOPGEN   3392
#define XCD_BAR_WORDS 3456
#define XB_SPIN_CAP (1u << 18)

__device__ __forceinline__ unsigned xb_ld(unsigned* p)              { return __hip_atomic_load(p, __ATOMIC_RELAXED, __HIP_MEMORY_SCOPE_AGENT); }
__device__ __forceinline__ unsigned xb_add(unsigned* p, unsigned v) { return __hip_atomic_fetch_add(p, v, __ATOMIC_RELAXED, __HIP_MEMORY_SCOPE_AGENT); }
__device__ __forceinline__ unsigned xb_xcc_id() { return (unsigned)__builtin_amdgcn_s_getreg((3 << 11) | 20) & 0xFu; }
#define XB_SPIN(cond, bar) do { unsigned _sp = 0; while (cond) { __builtin_amdgcn_s_sleep(1); \
    if ((++_sp & 255u) == 0u) { if (xb_ld(&(bar)[XB_TMO])) break; if (_sp > XB_SPIN_CAP) { atomicAdd(&(bar)[XB_TMO], 1u); break; } } } } while (0)

struct XcdBarrier {
    unsigned* bar; unsigned x;
    volatile LAS unsigned* st;
};

__device__ __forceinline__ XcdBarrier xcd_barrier_post(unsigned* bar, volatile LAS unsigned* st) {
    XcdBarrier b; b.bar = bar; b.x = xb_xcc_id(); b.st = st;
    if (threadIdx.x == 0) (void)xb_add(&bar[XB_XCNT(b.x)], 1u);
    return b;
}
__device__ __forceinline__ void xcd_barrier_complete(unsigned* bar, unsigned x, unsigned& nloc, unsigned& nx) {
    const unsigned G = gridDim.x * gridDim.y * gridDim.z;
    unsigned sum, cnt, mine, sp = 0u;
    for (;;) {
        sum = 0u; cnt = 0u; mine = 0u;
#pragma unroll
        for (unsigned j = 0; j < 16; ++j) { const unsigned c = xb_ld(&bar[XB_XCNT(j)]); sum += c; cnt += (c > 0u) ? 1u : 0u; mine = (j == x) ? c : mine; }
        if (sum == G) break;
        __builtin_amdgcn_s_sleep(1);
        if ((++sp & 255u) == 0u) { if (xb_ld(&bar[XB_TMO])) break; if (sp > XB_SPIN_CAP) { atomicAdd(&bar[XB_TMO], 1u); break; } }
    }
    nloc = mine > 0u ? mine : 1u; nx = cnt > 0u ? cnt : 1u;
}

__device__ __forceinline__ void xcd_barrier(const XcdBarrier& b) {
    asm volatile("s_waitcnt vmcnt(0)" ::: "memory");
    __syncthreads();
    if (threadIdx.x == 0) {
        unsigned* bar = b.bar;
        __builtin_amdgcn_s_waitcnt(0);
        unsigned nloc = b.st[0], nx = b.st[1];
        if (nloc == 0u) { xcd_barrier_complete(bar, b.x, nloc, nx); b.st[0] = nloc; b.st[1] = nx; }
        const unsigned old = xb_add(&bar[XB_XSUB(b.x)], 1u);
        const unsigned gen = old / nloc;
        if (old + 1u == (gen + 1u) * nloc) {
            __builtin_amdgcn_fence(__ATOMIC_RELEASE, "agent");
            asm volatile("s_waitcnt vmcnt(0)" ::: "memory");
            const unsigned og = xb_add(&bar[XB_TOP], 1u);
            const unsigned tg = og / nx;
            if (og + 1u == (tg + 1u) * nx) xb_add(&bar[XB_TOPGEN], 1u);
            else XB_SPIN(xb_ld(&bar[XB_TOPGEN]) == tg, bar);
            __builtin_amdgcn_fence(__ATOMIC_ACQUIRE, "agent");
            xb_add(&bar[XB_XGEN(b.x)], 1u);
            asm volatile("s_waitcnt vmcnt(0)" ::: "memory");
        } else {
            XB_SPIN(xb_ld(&bar[XB_XGEN(b.x)]) == gen, bar);
            __builtin_amdgcn_fence(__ATOMIC_ACQUIRE, "agent");
            asm volatile("s_waitcnt vmcnt(0)" ::: "memory");
        }
    }
    __syncthreads();
}

__device__ __forceinline__ void grp_barrier_complete(unsigned* bar, unsigned x, unsigned G, unsigned& nloc, unsigned& nx) {
    unsigned sum, cnt, mine, sp = 0u;
    for (;;) {
        sum = 0u; cnt = 0u; mine = 0u;
#pragma unroll
        for (unsigned j = 0; j < 16; ++j) { const unsigned c = xb_ld(&bar[XB_XCNT(j)]); sum += c; cnt += (c > 0u) ? 1u : 0u; mine = (j == x) ? c : mine; }
        if (sum == G) break;
        __builtin_amdgcn_s_sleep(1);
        if ((++sp & 255u) == 0u) { if (xb_ld(&bar[XB_TMO])) break; if (sp > XB_SPIN_CAP) { atomicAdd(&bar[XB_TMO], 1u); break; } }
    }
    nloc = mine > 0u ? mine : 1u; nx = cnt > 0u ? cnt : 1u;
}

__device__ __forceinline__ void grp_barrier(const XcdBarrier& b, unsigned gsz) {
    asm volatile("s_waitcnt vmcnt(0)" ::: "memory");
    __syncthreads();
    if (threadIdx.x == 0) {
        unsigned* bar = b.bar;
        __builtin_amdgcn_s_waitcnt(0);
        unsigned nloc = b.st[0], nx = b.st[1];
        if (nloc == 0u) { grp_barrier_complete(bar, b.x, gsz, nloc, nx); b.st[0] = nloc; b.st[1] = nx; }
        const unsigned old = xb_add(&bar[XB_XSUB(b.x)], 1u);
        const bool early = (nx == 1u);
        if (early) __builtin_amdgcn_fence(__ATOMIC_ACQUIRE, "agent");
        const unsigned gen = old / nloc;
        if (old + 1u == (gen + 1u) * nloc) {
            if (nx > 1u) __builtin_amdgcn_fence(__ATOMIC_RELEASE, "agent");
            if (!early) asm volatile("s_waitcnt vmcnt(0)" ::: "memory");
            if (!early) {
            const unsigned og = xb_add(&bar[XB_TOP], 1u);
            const unsigned tg = og / nx;
            if (og + 1u == (tg + 1u) * nx) xb_add(&bar[XB_TOPGEN], 1u);
            else XB_SPIN(xb_ld(&bar[XB_TOPGEN]) == tg, bar);
            }
            if (!early) __builtin_amdgcn_fence(__ATOMIC_ACQUIRE, "agent");
            xb_add(&bar[XB_XGEN(b.x)], 1u);
            asm volatile("s_waitcnt vmcnt(0)" ::: "memory");
        } else {
            XB_SPIN(xb_ld(&bar[XB_XGEN(b.x)]) == gen, bar);
            if (!early) __builtin_amdgcn_fence(__ATOMIC_ACQUIRE, "agent");
            asm volatile("s_waitcnt vmcnt(0)" ::: "memory");
        }
    }
    __syncthreads();
}

constexpr int NWAVES = 8, NTHREADS = 512;
constexpr int DM = 1024, MP = 16384, MS = 1024, MTOT = 17408;
constexpr int DFF = 4096, GINP = 3328, GIN = 3088;
constexpr float EPSN = 1e-6f;
constexpr float LOG2E = 1.4426950408889634f;
enum { I_XP = 0, I_XS, I_MEM, I_RGH, I_RGCONV, I_GLAS, I_CK, I_CV, I_NMIX, I_NXA, I_NMEM, I_NMLP, I_NFIN, I_RGWIN, I_RGCW, I_RGCB, I_RGWA, I_RGBA, I_RGWX, I_RGBX, I_RGLAM, I_RGWOUT,
       I_GLAWIN, I_GLAWA2, I_GLABA, I_GLANG, I_GLAWOUT, I_WQ, I_WK, I_WV, I_WO, I_W1, I_W2, N_IN };
constexpr size_t O_YP = 0, O_YS = 16777216, O_MK = 17825792, O_MV = 26214400, O_HP = 34603008, O_CP = 34619392, O_SP = 34668544, O_HS = 36765696, O_CS = 37027840, O_SS = 37814272, O_END = 71368704;
constexpr size_t MiB = 1u << 20;
constexpr size_t WS_CTL = 0, CTL_ZERO_BYTES = 1 * MiB;
constexpr size_t WS_WQ = 1 * MiB, WS_WO = 9 * MiB, WS_WKV = 17 * MiB, WS_W1 = 33 * MiB, WS_W2 = 65 * MiB, WS_RGWIN = 97 * MiB, WS_RGWOUT = 105 * MiB, WS_GLAWIN = 109 * MiB, WS_GLAWOUT = 122 * MiB, WS_WG = 126 * MiB;
constexpr size_t WS_X = 127 * MiB, WS_XB = 195 * MiB, WS_SSQ = 738 * MiB, WS_MN = 231 * MiB, WS_KPB = 235 * MiB, WS_VPB = 251 * MiB, WS_A1 = 267 * MiB, WS_A2 = 301 * MiB, WS_A3 = 335 * MiB;
constexpr size_t WS_H1 = 369 * MiB, WS_QKVG = 505 * MiB, WS_ALO = 607 * MiB, WS_DS = 609 * MiB, WS_SC = 673 * MiB, WS_GD = 737 * MiB, WS_LA = 741 * MiB, WS_END = 776 * MiB;
constexpr int CW_BAR = 4096;
constexpr int LDS_BYTES = 147456;
constexpr int MISC_OFF = 143360;
constexpr int KV_PITCH = 528;
constexpr int K128_PITCH = 272;

struct Args { const float* in[N_IN]; float* out; unsigned char* ws; };
#define CAS __attribute__((address_space(4)))
typedef const CAS Args* ArgsP;

DI f32x16 mfma32(bf16x8 a, bf16x8 b, f32x16 c) { return __builtin_amdgcn_mfma_f32_32x32x16_bf16(a, b, c, 0, 0, 0); }
DI f32x16 zero16() { f32x16 z;
#pragma unroll
    for (int i = 0; i < 16; ++i) z[i] = 0.f; return z; }
DI int crow(int i, int hh) { return (i & 3) + 8 * (i >> 2) + 4 * hh; }
DI bf16x8 tr_frag(LAS unsigned char* img, int pitch, int k0, int k1, int n0, int lane) {
    const int i16 = lane & 15, q4 = i16 >> 2, p4 = i16 & 3, blk = (lane >> 4) & 1;
    const int cb = (n0 + 16 * blk) * 2 + 8 * p4;
    const s16x4 lo = __builtin_amdgcn_ds_read_tr16_b64_v4i16((LAS s16x4*)(img + (k0 + q4) * pitch + cb));
    const s16x4 hi = __builtin_amdgcn_ds_read_tr16_b64_v4i16((LAS s16x4*)(img + (k1 + q4) * pitch + cb));
    return __builtin_shufflevector(lo, hi, 0, 1, 2, 3, 4, 5, 6, 7);
}
DI bf16x8 pack_step(const f32x16& x, int s, float scale) {
    u32x4 p;
    p.x = pk2(x[8 * s + 0] * scale, x[8 * s + 1] * scale); p.y = pk2(x[8 * s + 2] * scale, x[8 * s + 3] * scale);
    p.z = pk2(x[8 * s + 4] * scale, x[8 * s + 5] * scale); p.w = pk2(x[8 * s + 6] * scale, x[8 * s + 7] * scale);
    return __builtin_bit_cast(bf16x8, p);
}

DI void p0_item(const float* W, int ldw, int ncol_valid, int K, const float* rscale, int kmask, float cs, bf16* WT, LAS unsigned* scr, int kb, int nb, int lane) {
    const int k0 = 64 * kb, n0 = 64 * nb, n4 = lane & 15, kr = lane >> 4; const bool ok = n0 + 4 * n4 < ncol_valid;
    const float* src = W + (size_t)(k0 + 2 * kr) * ldw + n0 + 4 * n4;
    f32x4 va[8], vb[8];
#pragma unroll
    for (int i = 0; i < 8; ++i) { va[i] = (f32x4){0.f, 0.f, 0.f, 0.f}; vb[i] = va[i]; if (ok) { va[i] = __builtin_nontemporal_load((const f32x4*)(src + (size_t)(8 * i) * ldw)); vb[i] = __builtin_nontemporal_load((const f32x4*)(src + (size_t)(8 * i + 1) * ldw)); } }
#pragma unroll
    for (int i = 0; i < 8; ++i) { const int k = k0 + 2 * kr + 8 * i; float sa = cs, sb = cs; if (rscale) { sa *= rscale[k & kmask]; sb *= rscale[(k + 1) & kmask]; }
#pragma unroll
        for (int j = 0; j < 4; ++j) scr[(4 * n4 + j) * 33 + kr + 4 * i] = pk2(va[i][j] * sa, vb[i][j] * sb); }
    LDS_WAIT(); asm volatile("" ::: "memory");
    const int c = lane & 7;
#pragma unroll
    for (int jj = 0; jj < 8; ++jj) { const int n = (lane >> 3) + 8 * jj; const LAS unsigned* sp = scr + n * 33 + 4 * c;
        u32x4 o; o.x = sp[0]; o.y = sp[1]; o.z = sp[2]; o.w = sp[3];
        *(u32x4*)(WT + (size_t)(n0 + n) * K + k0 + 8 * c) = o; }
    LDS_WAIT(); asm volatile("" ::: "memory");
}
DI void p0_prologue(ArgsP A, LAS unsigned char* lds, int gw, int NGW, int wave, int lane0) {
    unsigned char* ws = A->ws;
    LAS unsigned* scr = (LAS unsigned*)(lds + wave * 16384);
    constexpr int PER_L = 3072, PER_J = 1888, N_L = 4 * PER_L, NITEMS = N_L + 2 * PER_J;
#pragma unroll 1
    for (int it = gw; it < NITEMS; it += NGW) {
        int lane = lane0; asm volatile("" : "+v"(lane));
        const float* W; int ldw, ncv, K, kmask = 0, kb, nb; const float* rsc = nullptr; float cs = 1.f; bf16* WT;
        if (it < N_L) {
            const int l = it / PER_L; int r = it % PER_L; ldw = DM; ncv = DM; K = DM;
            if (r < 256) { W = A->in[I_WQ] + (size_t)l * DM * DM; rsc = A->in[I_NXA] + l * DM; kmask = 1023; cs = 0.0625f; WT = (bf16*)(ws + WS_WQ) + (size_t)l * DM * DM; kb = r / 16; nb = r % 16; }
            else if ((r -= 256) < 256) { W = A->in[I_WO] + (size_t)l * DM * DM; WT = (bf16*)(ws + WS_WO) + (size_t)l * DM * DM; kb = r / 16; nb = r % 16; }
            else if ((r -= 256) < 256) { W = A->in[I_WK] + (size_t)l * DM * DM; rsc = A->in[I_NMEM] + l * DM; kmask = 1023; WT = (bf16*)(ws + WS_WKV) + (size_t)(l * 2048) * DM; kb = r / 16; nb = r % 16; }
            else if ((r -= 256) < 256) { W = A->in[I_WV] + (size_t)l * DM * DM; rsc = A->in[I_NMEM] + l * DM; kmask = 1023; WT = (bf16*)(ws + WS_WKV) + (size_t)(l * 2048 + 1024) * DM; kb = r / 16; nb = r % 16; }
            else if ((r -= 256) < 1024) { W = A->in[I_W1] + (size_t)l * DM * DFF; ldw = DFF; ncv = DFF; rsc = A->in[I_NMLP] + l * DM; kmask = 1023; WT = (bf16*)(ws + WS_W1) + (size_t)l * DFF * DM; kb = r / 64; nb = r % 64; }
            else { r -= 1024; W = A->in[I_W2] + (size_t)l * DFF * DM; K = DFF; WT = (bf16*)(ws + WS_W2) + (size_t)l * DM * DFF; kb = r / 16; nb = r % 16; }
        } else {
            const int r2 = it - N_L; const int j = r2 / PER_J; int r = r2 % PER_J; ldw = DM; ncv = DM; K = DM;
            if (r < 512) { W = A->in[I_RGWIN] + (size_t)j * DM * 2048; ldw = 2048; ncv = 2048; rsc = A->in[I_NMIX] + (2 * j) * DM; kmask = 1023; WT = (bf16*)(ws + WS_RGWIN) + (size_t)j * 2048 * DM; kb = r / 32; nb = r % 32; }
            else if ((r -= 512) < 256) { W = A->in[I_RGWOUT] + (size_t)j * DM * DM; WT = (bf16*)(ws + WS_RGWOUT) + (size_t)j * DM * DM; kb = r / 16; nb = r % 16; }
            else if ((r -= 256) < 832) { W = A->in[I_GLAWIN] + (size_t)j * DM * GIN; ldw = GIN; ncv = GIN; rsc = A->in[I_NMIX] + (2 * j + 1) * DM; kmask = 1023; kb = r / 52; nb = r % 52; cs = nb < 8 ? 0.08838834764831845f : 1.f; WT = (bf16*)(ws + WS_GLAWIN) + (size_t)j * GINP * DM; }
            else if ((r -= 832) < 256) { W = A->in[I_GLAWOUT] + (size_t)j * DM * DM; rsc = A->in[I_GLANG] + j * 256; kmask = 255; WT = (bf16*)(ws + WS_GLAWOUT) + (size_t)j * DM * DM; kb = r / 16; nb = r % 16; }
            else if ((r -= 256) < 16) { W = A->in[I_RGWA] + (size_t)j * 16 * 64 * 64; ldw = 64; ncv = 64; WT = (bf16*)(ws + WS_WG) + (size_t)(j * 2 + 0) * 64 * DM; kb = r; nb = 0; }
            else { r -= 16; W = A->in[I_RGWX] + (size_t)j * 16 * 64 * 64; ldw = 64; ncv = 64; WT = (bf16*)(ws + WS_WG) + (size_t)(j * 2 + 1) * 64 * DM; kb = r; nb = 0; }
        }
        p0_item(W, ldw, ncv, K, rsc, kmask, cs, WT, scr, kb, nb, lane);
    }
    const int lane = lane0;
    bf16* XB = (bf16*)(ws + WS_XB); float* SS = (float*)(ws + WS_SSQ);
    for (int m = gw; m < MTOT; m += NGW) {
        const float* src = m < MP ? A->in[I_XP] + (size_t)m * DM : A->in[I_XS] + (size_t)(m - MP) * DM;
        f32x4 v[4]; float s = 0.f;
#pragma unroll
        for (int jq = 0; jq < 4; ++jq) { v[jq] = __builtin_nontemporal_load((const f32x4*)src + 64 * jq + lane); s += (v[jq][0] * v[jq][0] + v[jq][1] * v[jq][1]) + (v[jq][2] * v[jq][2] + v[jq][3] * v[jq][3]); }
        s = wave_sum(s);
#pragma unroll
        for (int jq = 0; jq < 4; ++jq) { u32x2 w; w.x = pk2(v[jq][0], v[jq][1]); w.y = pk2(v[jq][2], v[jq][3]); ((u32x2*)(XB + (size_t)m * DM))[64 * jq + lane] = w; }
        if (lane < 32) SS[(size_t)m * 32 + lane] = lane == 0 ? s : 0.f;
    }
    bf16* MN = (bf16*)(ws + WS_MN);
    for (int m = gw; m < 2048; m += NGW) {
        const float* src = A->in[I_MEM] + (size_t)m * DM;
        f32x4 v[4]; float s = 0.f;
#pragma unroll
        for (int jq = 0; jq < 4; ++jq) { v[jq] = __builtin_nontemporal_load((const f32x4*)src + 64 * jq + lane); s += (v[jq][0] * v[jq][0] + v[jq][1] * v[jq][1]) + (v[jq][2] * v[jq][2] + v[jq][3] * v[jq][3]); }
        s = wave_sum(s); const float rstd = __builtin_amdgcn_rsqf(s * (1.f / 1024.f) + EPSN);
#pragma unroll
        for (int jq = 0; jq < 4; ++jq) { u32x2 w; w.x = pk2(v[jq][0] * rstd, v[jq][1] * rstd); w.y = pk2(v[jq][2] * rstd, v[jq][3] * rstd); ((u32x2*)(MN + (size_t)m * DM))[64 * jq + lane] = w; }
    }
}

template <int RA, int NP, int NS, int KT, class R8>
DI void small_gemm(LAS unsigned char* lds, const bf16* __restrict__ A, const bf16* __restrict__ Bt, int K, int row_base, int col_base, const R8& e, int tid, int wave, int lane) {
    constexpr int WR = 4 / RA, WC = 8 / WR, C = WC * NP / 2, SUB = (1 + C) * 8192, STAGE = KT * SUB, L = KT * (1 + C);
    static_assert(NS * STAGE <= 131072 && (NS - 2) * L <= 63, "ring");
    const int wr = wave / WC, wc = wave % WC, fr = lane & 15, fq = lane >> 4;
    int R, Cc; pg8::stage_rc(tid * 16, R, Cc);
    const int Rb = (R & ~31) + pg8::perm32(R & 31);
    const bf16* asrc = A + (size_t)(row_base + R) * K + Cc;
    const bf16* bsrc = Bt + (size_t)(col_base + Rb) * K + Cc;
    const size_t bgrp = (size_t)64 * K;
    const int NT = K / (64 * KT);
#define SG_STAGE(st_, slot_) do { const int stw_ = (st_) & (NT - 1); LAS unsigned char* sb_ = lds + (slot_) * STAGE + wave * 1024; \
        _Pragma("unroll") for (int t_ = 0; t_ < KT; ++t_) { const int ko_ = 64 * (KT * stw_ + t_); \
            __builtin_amdgcn_global_load_lds((const unsigned*)(asrc + ko_), (LAS unsigned*)(sb_ + t_ * SUB), 16, 0, 0); \
            _Pragma("unroll") for (int g_ = 0; g_ < C; ++g_) __builtin_amdgcn_global_load_lds((const unsigned*)(bsrc + g_ * bgrp + ko_), (LAS unsigned*)(sb_ + t_ * SUB + 8192 * (1 + g_)), 16, 0, 0); } } while (0)
    const int r0 = row_base + 16 * (wr * RA), c0 = col_base + wc * (32 * NP);
    float rsv[RA]; u32x4 prew[RA][NP];
#pragma unroll
    for (int ra = 0; ra < RA; ++ra) { rsv[ra] = 1.f; if constexpr (R8::NEED_RS) rsv[ra] = pg8::rs_of_row(e.SS, r0 + 16 * ra + fr, fq);
#pragma unroll
        for (int np = 0; np < NP; ++np) { prew[ra][np] = (u32x4){0u, 0u, 0u, 0u}; if constexpr (R8::HAS_PRE) prew[ra][np] = e.pre(r0 + 16 * ra + fr, c0 + 32 * np + 8 * fq); } }
    f32x4 acc[RA][NP][2];
#pragma unroll
    for (int ra = 0; ra < RA; ++ra)
#pragma unroll
        for (int np = 0; np < NP; ++np) { acc[ra][np][0] = (f32x4){0.f, 0.f, 0.f, 0.f}; acc[ra][np][1] = (f32x4){0.f, 0.f, 0.f, 0.f}; }
    int aoff[RA], boff[NP][2];
#pragma unroll
    for (int ra = 0; ra < RA; ++ra) aoff[ra] = pg8::lds_byte(16 * (wr * RA + ra) + fr, 8 * fq);
#pragma unroll
    for (int np = 0; np < NP; ++np)
#pragma unroll
        for (int n = 0; n < 2; ++n) { const int rb = wc * (32 * NP) + 32 * np + 16 * n + fr; boff[np][n] = 8192 * (1 + (rb >> 6)) + pg8::lds_byte(rb & 63, 8 * fq); }
#pragma unroll
    for (int s = 0; s < NS - 1; ++s) SG_STAGE(s, s);
#pragma unroll 1
    for (int st = 0; st < NT; ++st) {
        asm volatile("s_waitcnt vmcnt(%0)" :: "n"((NS - 2) * L) : "memory");
        __builtin_amdgcn_s_barrier();
        asm volatile("" ::: "memory");
        { const int nslot = (st + NS - 1) % NS; SG_STAGE(st + NS - 1, nslot); }
        const LAS unsigned char* sb0 = lds + (st % NS) * STAGE;
#pragma unroll
        for (int t = 0; t < KT; ++t) {
            const LAS unsigned char* sb = sb0 + t * SUB;
            bf16x8 af[RA][2], bfr[NP][2][2];
#pragma unroll
            for (int ra = 0; ra < RA; ++ra) { af[ra][0] = *(const LAS bf16x8*)(sb + aoff[ra]); af[ra][1] = *(const LAS bf16x8*)(sb + aoff[ra] + 1024); }
#pragma unroll
            for (int np = 0; np < NP; ++np)
#pragma unroll
                for (int n = 0; n < 2; ++n) { bfr[np][n][0] = *(const LAS bf16x8*)(sb + boff[np][n]); bfr[np][n][1] = *(const LAS bf16x8*)(sb + boff[np][n] + 1024); }
#pragma unroll
            for (int ks = 0; ks < 2; ++ks)
#pragma unroll
                for (int ra = 0; ra < RA; ++ra)
#pragma unroll
                    for (int np = 0; np < NP; ++np) { acc[ra][np][0] = __builtin_amdgcn_mfma_f32_16x16x32_bf16(bfr[np][0][ks], af[ra][ks], acc[ra][np][0], 0, 0, 0); acc[ra][np][1] = __builtin_amdgcn_mfma_f32_16x16x32_bf16(bfr[np][1][ks], af[ra][ks], acc[ra][np][1], 0, 0, 0); }
        }
    }
#undef SG_STAGE
    asm volatile("s_waitcnt vmcnt(0)" ::: "memory");
    __builtin_amdgcn_s_barrier();
    asm volatile("" ::: "memory");
#pragma unroll
    for (int ra = 0; ra < RA; ++ra) {
        const int row = r0 + 16 * ra + fr;
#pragma unroll
        for (int np = 0; np < NP; ++np) {
            if constexpr (R8::HAS_PRE) e.row8p(row, c0 + 32 * np + 8 * fq, acc[ra][np][0], acc[ra][np][1], prew[ra][np], fq);
            else e.row8(row, c0 + 32 * np + 8 * fq, acc[ra][np][0], acc[ra][np][1], rsv[ra], fq);
        }
    }
}
DI float log_sigmoid_f(float x) { return fminf(x, 0.f) - 0.6931471805599453f * __builtin_amdgcn_logf(1.0f + fexp(-__builtin_fabsf(x))); }
DI void la_unit(const bf16* __restrict__ XB, const bf16* __restrict__ W16, const float* SS, const float* __restrict__ wa2, const float* __restrict__ ba, float* __restrict__ LA, LAS float* scr, int row0, int lane) {
    const int fr = lane & 15, fq = lane >> 4;
    const bf16* ap = XB + (size_t)(row0 + fr) * DM + 8 * fq; const bf16* bp = W16 + (size_t)fr * DM + 8 * fq;
    f32x4 acc = (f32x4){0.f, 0.f, 0.f, 0.f};
#pragma unroll 8
    for (int k0 = 0; k0 < DM; k0 += 32) acc = __builtin_amdgcn_mfma_f32_16x16x32_bf16(*(const bf16x8*)(bp + k0), *(const bf16x8*)(ap + k0), acc, 0, 0, 0);
    const float rs = pg8::rs_of_row(SS, row0 + fr, fq);
    *(LAS f32x4*)(scr + fr * 16 + 4 * fq) = acc * rs;
    LDS_WAIT(); asm volatile("" ::: "memory");
#pragma unroll 1
    for (int nb = 0; nb < 8; ++nb) {
        float w[16];
#pragma unroll
        for (int rk = 0; rk < 16; ++rk) w[rk] = wa2[rk * 512 + 64 * nb + lane];
        const float bb = ba[64 * nb + lane];
#pragma unroll 4
        for (int row = 0; row < 16; ++row) {
            const f32x4 a0 = *(const LAS f32x4*)(scr + row * 16), a1 = *(const LAS f32x4*)(scr + row * 16 + 4), a2 = *(const LAS f32x4*)(scr + row * 16 + 8), a3 = *(const LAS f32x4*)(scr + row * 16 + 12);
            float pre = bb;
#pragma unroll
            for (int q = 0; q < 4; ++q) pre += a0[q] * w[q] + a1[q] * w[4 + q] + a2[q] * w[8 + q] + a3[q] * w[12 + q];
            LA[(size_t)(row0 + row) * 512 + 64 * nb + lane] = log_sigmoid_f(pre) * 0.0625f;
        }
    }
    LDS_WAIT(); asm volatile("" ::: "memory");
}

DI void attn_stage_kv(LAS unsigned char* lds, const bf16* KVP, int b, int h, int tid) {
    const bf16* kbase = KVP + (size_t)(b * 256) * DM + h * 256;
    u32x4 v[16];
#pragma unroll
    for (int i = 0; i < 16; ++i) { const int id = tid + 512 * i, m = id >> 5, ch = id & 31; v[i] = *(const u32x4*)(kbase + (size_t)m * DM + ch * 8); }
#pragma unroll
    for (int i = 0; i < 16; ++i) { const int id = tid + 512 * i, m = id >> 5, ch = id & 31; *(LAS u32x4*)(lds + m * KV_PITCH + ch * 16) = v[i]; }
}
DI void attn_prompt_unit(LAS unsigned char* lds, const bf16* Q, const bf16* KP, const bf16* VP, bf16* AO, int b, int h, int qt, int tid, int wave, int lane, bool k_staged) {
    const int r = lane & 31, hh = lane >> 5;
    const int q0 = b * 2048 + qt * 256 + wave * 32;
    const bf16* qrow = Q + (size_t)(q0 + r) * DM + h * 256 + 8 * hh;
    bf16x8 bq[3][2];
#pragma unroll
    for (int c = 0; c < 2; ++c) { bq[0][c] = *(const bf16x8*)(qrow + 16 * c); bq[1][c] = *(const bf16x8*)(qrow + 16 * (2 + c)); }
    if (!k_staged) attn_stage_kv(lds, KP, b, h, tid);
    __syncthreads();
    f32x16 acc[8];
#pragma unroll
    for (int mt = 0; mt < 8; ++mt) acc[mt] = zero16();
#pragma unroll
    for (int g = 0; g < 8; ++g) {
        if (g < 6) {
#pragma unroll
            for (int c = 0; c < 2; ++c) bq[(g + 2) % 3][c] = *(const bf16x8*)(qrow + 16 * (2 * (g + 2) + c)); }
#pragma unroll
        for (int c = 0; c < 2; ++c) { const int kk = 2 * g + c;
#pragma unroll
            for (int mt = 0; mt < 8; ++mt) { const bf16x8 a = *(const LAS bf16x8*)(lds + (32 * mt + r) * KV_PITCH + (16 * kk + 8 * hh) * 2); acc[mt] = mfma32(a, bq[g % 3][c], acc[mt]); }
            __builtin_amdgcn_sched_barrier(0);
        }
    }
    float mx = -3.0e38f;
#pragma unroll
    for (int mt = 0; mt < 8; ++mt)
#pragma unroll
        for (int i = 0; i < 16; ++i) mx = fmaxf(mx, acc[mt][i]);
    mx = xmax32(mx);
    float sum = 0.f;
#pragma unroll
    for (int mt = 0; mt < 8; ++mt)
#pragma unroll
        for (int i = 0; i < 16; ++i) { const float p = __builtin_amdgcn_exp2f((acc[mt][i] - mx) * LOG2E); acc[mt][i] = p; sum += p; }
    sum = xsum32(sum);
    const float inv = frcp(sum);
    bf16x8 pf[8][2];
#pragma unroll
    for (int mt = 0; mt < 8; ++mt) { pf[mt][0] = pack_step(acc[mt], 0, inv); pf[mt][1] = pack_step(acc[mt], 1, inv); }
    __syncthreads();
    attn_stage_kv(lds, VP, b, h, tid);
    __syncthreads();
#pragma unroll
    for (int half = 0; half < 2; ++half) {
        f32x16 z[4];
#pragma unroll
        for (int d = 0; d < 4; ++d) z[d] = zero16();
#pragma unroll
        for (int mt = 0; mt < 8; ++mt)
#pragma unroll
            for (int ss = 0; ss < 2; ++ss) { const int k0 = 32 * mt + 16 * ss + 4 * hh;
#pragma unroll
                for (int d = 0; d < 4; ++d) { const bf16x8 bv = tr_frag(lds, KV_PITCH, k0, k0 + 8, 32 * (4 * half + d), lane); z[d] = mfma32(pf[mt][ss], bv, z[d]); } }
#pragma unroll
        for (int d = 0; d < 4; ++d)
#pragma unroll
            for (int i = 0; i < 16; ++i) AO[(size_t)(q0 + crow(i, hh)) * DM + h * 256 + 32 * (4 * half + d) + r] = f2bf(z[d][i]);
    }
}
DI void attn_sample_unit(LAS unsigned char* lds, const bf16* Q, const float* CK, const float* CV, bf16* AO, int su, int tid, int wave, int lane) {
    const int pair = wave >> 2, mq = wave & 3, bh = su * 2 + pair, b = bh >> 2, h = bh & 3;
    LAS unsigned char* wl = lds + wave * 16896;
    const int r = lane & 31, hh = lane >> 5;
    bf16x8 bq[16];
    {   const bf16* qrow = Q + (size_t)(MP + b * 8 + (r & 7)) * DM + h * 256 + 8 * hh;
#pragma unroll
        for (int kk = 0; kk < 16; ++kk) { bf16x8 v = *(const bf16x8*)(qrow + 16 * kk); if (r >= 8) { v = (bf16x8){0, 0, 0, 0, 0, 0, 0, 0}; } bq[kk] = v; } }
    const float* kb = CK + ((size_t)(b * 256 + 64 * mq) * 4 + h) * 256 + 4 * lane;
    f32x16 acc[2];
    const float* vb = CV + ((size_t)(b * 256 + 64 * mq) * 4 + h) * 256 + 4 * lane;
    f32x4 v[16];
#pragma unroll
    for (int i = 0; i < 16; ++i) v[i] = __builtin_nontemporal_load((const f32x4*)(kb + (size_t)i * 1024));
#pragma unroll
    for (int c = 0; c < 2; ++c) {
#pragma unroll
        for (int hf = 0; hf < 2; ++hf) {
#pragma unroll
            for (int i = 0; i < 16; ++i) { u32x2 w; w.x = pk2(v[i][0], v[i][1]); w.y = pk2(v[i][2], v[i][3]); *(LAS u32x2*)(wl + (16 * hf + i) * KV_PITCH + lane * 8) = w; }
            const int nb = 2 * c + hf + 1;
#pragma unroll
            for (int i = 0; i < 16; ++i) v[i] = __builtin_nontemporal_load(nb < 4 ? (const f32x4*)(kb + (size_t)(16 * nb + i) * 1024) : (const f32x4*)(vb + (size_t)i * 1024));
        }
        f32x16 a_ = zero16();
#pragma unroll
        for (int kk = 0; kk < 16; ++kk) { const bf16x8 a = *(const LAS bf16x8*)(wl + r * KV_PITCH + (16 * kk + 8 * hh) * 2); a_ = mfma32(a, bq[kk], a_); }
        acc[c] = a_;
    }
    float mx = -3.0e38f;
#pragma unroll
    for (int c = 0; c < 2; ++c)
#pragma unroll
        for (int i = 0; i < 16; ++i) mx = fmaxf(mx, acc[c][i]);
    mx = xmax32(mx);
    float sum = 0.f;
#pragma unroll
    for (int c = 0; c < 2; ++c)
#pragma unroll
        for (int i = 0; i < 16; ++i) { const float p = __builtin_amdgcn_exp2f((acc[c][i] - mx) * LOG2E); acc[c][i] = p; sum += p; }
    sum = xsum32(sum);
    LAS float* Pbuf = (LAS float*)wl;
    if (r < 8) {
#pragma unroll
        for (int c = 0; c < 2; ++c)
#pragma unroll
            for (int i = 0; i < 16; ++i) Pbuf[(32 * c + crow(i, hh)) * 8 + r] = acc[c][i];
    }
    LDS_WAIT(); asm volatile("" ::: "memory");
    f32x4 o[8];
#pragma unroll
    for (int q = 0; q < 8; ++q) o[q] = (f32x4){0.f, 0.f, 0.f, 0.f};
#pragma unroll
    for (int mb = 0; mb < 4; ++mb) {
        f32x4 v2[16];
        if (mb < 3) {
#pragma unroll
            for (int i = 0; i < 16; ++i) v2[i] = __builtin_nontemporal_load((const f32x4*)(vb + (size_t)(16 * (mb + 1) + i) * 1024)); }
#pragma unroll
        for (int i = 0; i < 16; ++i) { const f32x4 p0 = *(const LAS f32x4*)(Pbuf + (16 * mb + i) * 8), p1 = *(const LAS f32x4*)(Pbuf + (16 * mb + i) * 8 + 4);
            o[0] += v[i] * p0[0]; o[1] += v[i] * p0[1]; o[2] += v[i] * p0[2]; o[3] += v[i] * p0[3]; o[4] += v[i] * p1[0]; o[5] += v[i] * p1[1]; o[6] += v[i] * p1[2]; o[7] += v[i] * p1[3]; }
        if (mb < 3) {
#pragma unroll
            for (int i = 0; i < 16; ++i) v[i] = v2[i]; }
    }
    LAS float* Op = (LAS float*)(wl + 2048);
    LAS float* St = (LAS float*)(wl + 2048 + 8192);
#pragma unroll
    for (int q = 0; q < 8; ++q) *(LAS f32x4*)(Op + q * 256 + 4 * lane) = o[q];
    if (lane < 8) { St[lane * 2] = mx; St[lane * 2 + 1] = sum; }
    __syncthreads();
    {   const int d = 64 * mq + lane;
#pragma unroll
        for (int q = 0; q < 8; ++q) {
            float m4[4], l4[4], o4[4]; float M = -3.0e38f;
#pragma unroll
            for (int w = 0; w < 4; ++w) { LAS unsigned char* ow = lds + (pair * 4 + w) * 16896; m4[w] = ((LAS float*)(ow + 2048 + 8192))[q * 2]; l4[w] = ((LAS float*)(ow + 2048 + 8192))[q * 2 + 1]; o4[w] = ((LAS float*)(ow + 2048))[q * 256 + d]; M = fmaxf(M, m4[w]); }
            float num = 0.f, den = 0.f;
#pragma unroll
            for (int w = 0; w < 4; ++w) { const float e = __builtin_amdgcn_exp2f((m4[w] - M) * LOG2E); num += e * o4[w]; den += e * l4[w]; }
            AO[(size_t)(MP + b * 8 + q) * DM + h * 256 + d] = f2bf(num / den);
        }
    }
}

constexpr int XS_PITCH = 144;
struct RgTile { float hl[16], ac[16]; float A0[4], B0[4], A1[4], B1[4]; };
template <bool SAMPLE>
DI void rg_tile(LAS unsigned char* xs, const LAS float* cw, const bf16x8 (&Ba)[4], const bf16x8 (&Bx)[4], float ba, float bx, float spn, const float (&cwo)[5], int nt, int lane, RgTile& T) {
    const int r = lane & 31, hh = lane >> 5;
    const int rA = SAMPLE ? 11 * (r >> 3) + (r & 7) : r;
    f32x16 R = zero16(), I = zero16();
#pragma unroll
    for (int kk = 0; kk < 4; ++kk) {
        const int c8 = 16 * kk + 8 * hh;
        float a[8];
        { const f32x4 b0 = *(const LAS f32x4*)(cw + 256 + c8), b1 = *(const LAS f32x4*)(cw + 256 + c8 + 4); a[0] = b0[0]; a[1] = b0[1]; a[2] = b0[2]; a[3] = b0[3]; a[4] = b1[0]; a[5] = b1[1]; a[6] = b1[2]; a[7] = b1[3]; }
#pragma unroll
        for (int j = 0; j < 4; ++j) {
            const u32x4 xv = *(const LAS u32x4*)(xs + (rA + j) * XS_PITCH + c8 * 2);
            const f32x4 w0 = *(const LAS f32x4*)(cw + j * 64 + c8), w1 = *(const LAS f32x4*)(cw + j * 64 + c8 + 4);
            a[0] += w0[0] * bf_lo(xv.x); a[1] += w0[1] * bf_hi(xv.x); a[2] += w0[2] * bf_lo(xv.y); a[3] += w0[3] * bf_hi(xv.y);
            a[4] += w1[0] * bf_lo(xv.z); a[5] += w1[1] * bf_hi(xv.z); a[6] += w1[2] * bf_lo(xv.w); a[7] += w1[3] * bf_hi(xv.w);
        }
        u32x4 p; p.x = pk2(a[0], a[1]); p.y = pk2(a[2], a[3]); p.z = pk2(a[4], a[5]); p.w = pk2(a[6], a[7]);
        const bf16x8 af = __builtin_bit_cast(bf16x8, p);
        R = mfma32(af, Ba[kk], R); I = mfma32(af, Bx[kk], I);
    }
    const LAS unsigned char* xc0 = xs + (32 * nt + r) * 2;
#pragma unroll
    for (int g = 0; g < 4; ++g) {
        const int rb = SAMPLE ? 11 * g + 4 * hh : 8 * g + 4 * hh;
        float xw[7];
#pragma unroll
        for (int j = 0; j < 7; ++j) xw[j] = bf2f(*(const LAS bf16*)(xc0 + (rb + j) * XS_PITCH));
        float hprev = 0.f, aprev = 1.f;
#pragma unroll
        for (int k = 0; k < 4; ++k) {
            const int i = 4 * g + k;
            const float xc = cwo[4] + cwo[0] * xw[k] + cwo[1] * xw[k + 1] + cwo[2] * xw[k + 2] + cwo[3] * xw[k + 3];
            const float rr = fsigmoid(R[i] + ba), ii = fsigmoid(I[i] + bx);
            const float la = spn * rr;
            const float a = fexp(la);
            const float mult = __builtin_amdgcn_sqrtf(fmaxf(1.0f - a * a, 0.f));
            const float bt = mult * ii * xc;
            hprev = a * hprev + bt; aprev = aprev * a;
            T.hl[i] = hprev; T.ac[i] = aprev;
        }
        halves32(aprev, T.A0[g], T.A1[g]); halves32(hprev, T.B0[g], T.B1[g]);
    }
}
DI void rg_unit_setup(ArgsP A, int j, int cb, int nt, int lane, LAS float* cw, bf16x8 (&Ba)[4], bf16x8 (&Bx)[4], float& ba, float& bx, float& spn, float (&cwo)[5]) {
    const int r = lane & 31, hh = lane >> 5, cho = cb * 64 + 32 * nt + r;
    const bf16* WG = (const bf16*)(A->ws + WS_WG) + (size_t)(j * 2) * 64 * DM;
#pragma unroll
    for (int kk = 0; kk < 4; ++kk) { Ba[kk] = *(const bf16x8*)(WG + (size_t)(32 * nt + r) * DM + cb * 64 + 16 * kk + 8 * hh); Bx[kk] = *(const bf16x8*)(WG + (size_t)64 * DM + (size_t)(32 * nt + r) * DM + cb * 64 + 16 * kk + 8 * hh); }
    ba = A->in[I_RGBA][j * DM + cho]; bx = A->in[I_RGBX][j * DM + cho];
    const float lam = A->in[I_RGLAM][j * DM + cho];
    spn = -8.0f * log1pf(expf(-lam));
#pragma unroll
    for (int q = 0; q < 4; ++q) { cwo[q] = A->in[I_RGCW][(size_t)(j * 4 + q) * DM + cho]; cw[q * 64 + lane] = A->in[I_RGCW][(size_t)(j * 4 + q) * DM + cb * 64 + lane]; }
    cwo[4] = A->in[I_RGCB][j * DM + cho]; cw[256 + lane] = A->in[I_RGCB][j * DM + cb * 64 + lane];
}
struct RgPre { u32x4 xv[5], gv[2]; };
DI void rg_prefetch(const bf16* XBR, const bf16* GATE, int b, int chA, int cho0, int t0, int lane, RgPre& P) {
#pragma unroll
    for (int i = 0; i < 5; ++i) { const int id = lane + 64 * i, row = id >> 3, c16 = id & 7, t = t0 - 3 + row; u32x4 v = (u32x4){0u, 0u, 0u, 0u};
        if (id < 280 && t >= 0) v = *(const u32x4*)(XBR + (size_t)(b * 2048 + t) * DM + chA + c16 * 8); P.xv[i] = v; }
#pragma unroll
    for (int i = 0; i < 2; ++i) { const int id = lane + 64 * i, row = id >> 2, c4 = id & 3; P.gv[i] = *(const u32x4*)(GATE + (size_t)(b * 2048 + t0 + row) * DM + cho0 + 8 * c4); }
}
DI void rg_prompt_unit(ArgsP A, LAS unsigned char* lds, int j, int b, int cb, int nt, int wave, int lane) {
    const int r = lane & 31, hh = lane >> 5, cho0 = cb * 64 + 32 * nt, cho = cho0 + r, chA = cb * 64;
    LAS unsigned char* xs = lds + wave * 6400;
    LAS float* cw = (LAS float*)(lds + 51200 + wave * 1280);
    LAS float* TM = (LAS float*)(lds + 61440);
    LAS unsigned char* gs = lds + 65536 + wave * 5120;
    LAS unsigned char* os = gs + 2560;
    const bf16* XBR = (const bf16*)(A->ws + WS_A2); const bf16* GATE = (const bf16*)(A->ws + WS_A1); bf16* HG = (bf16*)(A->ws + WS_A3);
    bf16x8 Ba[4], Bx[4]; float ba, bx, spn, cwo[5];
    rg_unit_setup(A, j, cb, nt, lane, cw, Ba, Bx, ba, bx, spn, cwo);
    RgPre P; rg_prefetch(XBR, GATE, b, chA, cho0, 32 * wave, lane, P);
    float carry = 0.f;
#pragma unroll 1
    for (int ss = 0; ss < 8; ++ss) {
        const int t0 = 256 * ss + 32 * wave;
#pragma unroll
        for (int i = 0; i < 5; ++i) { const int id = lane + 64 * i; if (id < 280) *(LAS u32x4*)(xs + (id >> 3) * XS_PITCH + (id & 7) * 16) = P.xv[i]; }
#pragma unroll
        for (int i = 0; i < 2; ++i) { const int id = lane + 64 * i; *(LAS u32x4*)(gs + (id >> 2) * 80 + (id & 3) * 16) = P.gv[i]; }
        if (ss < 7) rg_prefetch(XBR, GATE, b, chA, cho0, t0 + 256, lane, P);
        RgTile T;
        rg_tile<false>(xs, cw, Ba, Bx, ba, bx, spn, cwo, nt, lane, T);
        float TA = 1.f, TB = 0.f;
#pragma unroll
        for (int g = 0; g < 4; ++g) { TB = T.A0[g] * TB + T.B0[g]; TA *= T.A0[g]; TB = T.A1[g] * TB + T.B1[g]; TA *= T.A1[g]; }
        LAS float* tm = TM + (ss & 1) * 512;
        if (hh == 0) { tm[(wave * 32 + r) * 2] = TA; tm[(wave * 32 + r) * 2 + 1] = TB; }
        asm volatile("s_waitcnt lgkmcnt(0)" ::: "memory"); __builtin_amdgcn_s_barrier(); asm volatile("" ::: "memory");
        float cin = carry, cfull = carry;
#pragma unroll
        for (int w = 0; w < 8; ++w) { const float a = tm[(w * 32 + r) * 2], bb = tm[(w * 32 + r) * 2 + 1]; cfull = a * cfull + bb; if (w < wave) cin = cfull; }
        float cg = cin;
#pragma unroll
        for (int g = 0; g < 4; ++g) {
            const float c0 = cg, c1 = T.A0[g] * c0 + T.B0[g]; cg = T.A1[g] * c1 + T.B1[g];
            const float ci = hh ? c1 : c0;
#pragma unroll
            for (int k = 0; k < 4; ++k) { const int i = 4 * g + k; const float hv = T.hl[i] + T.ac[i] * ci; const int tl = 8 * g + 4 * hh + k;
                *(LAS bf16*)(os + tl * 80 + r * 2) = f2bf(bf2f(*(const LAS bf16*)(gs + tl * 80 + r * 2)) * hv); }
        }
        LDS_WAIT(); asm volatile("" ::: "memory");
#pragma unroll
        for (int i = 0; i < 2; ++i) { const int id = lane + 64 * i, row = id >> 2, c4 = id & 3; *(u32x4*)(HG + (size_t)(b * 2048 + t0 + row) * DM + cho0 + 8 * c4) = *(const LAS u32x4*)(os + row * 80 + c4 * 16); }
        carry = cfull;
    }
    if (wave == 0 && hh == 0) A->out[O_HP + (size_t)(j * 8 + b) * DM + cho] = carry;
}
DI void rg_sample_unit(ArgsP A, LAS unsigned char* lds, int j, int wu, int wave, int lane) {
    const int nt = wu & 1, cb = (wu >> 1) & 15, sg = wu >> 5;
    const int r = lane & 31, hh = lane >> 5, cho = cb * 64 + 32 * nt + r, chA = cb * 64;
    LAS unsigned char* xs = lds + wave * 6400;
    LAS float* cw = (LAS float*)(lds + 51200 + wave * 1280);
    const bf16* XBR = (const bf16*)(A->ws + WS_A2); const bf16* GATE = (const bf16*)(A->ws + WS_A1); bf16* HG = (bf16*)(A->ws + WS_A3);
    bf16x8 Ba[4], Bx[4]; float ba, bx, spn, cwo[5];
    rg_unit_setup(A, j, cb, nt, lane, cw, Ba, Bx, ba, bx, spn, cwo);
#pragma unroll
    for (int i = 0; i < 6; ++i) { const int id = lane + 64 * i; if (id < 352) { const int row = id >> 3, c16 = id & 7, sq = row / 11, rr = row - 11 * sq, bb = 4 * sg + sq; u32x4 v;
            if (rr < 3) { const float* cp = A->in[I_RGCONV] + ((size_t)(j * 128 + bb) * 3 + rr) * DM + chA + c16 * 8; const f32x4 f0 = *(const f32x4*)cp, f1 = *(const f32x4*)(cp + 4);
                v.x = pk2(f0[0], f0[1]); v.y = pk2(f0[2], f0[3]); v.z = pk2(f1[0], f1[1]); v.w = pk2(f1[2], f1[3]); }
            else v = *(const u32x4*)(XBR + (size_t)(MP + bb * 8 + rr - 3) * DM + chA + c16 * 8);
            *(LAS u32x4*)(xs + row * XS_PITCH + c16 * 16) = v; } }
    RgTile T;
    rg_tile<true>(xs, cw, Ba, Bx, ba, bx, spn, cwo, nt, lane, T);
#pragma unroll
    for (int g = 0; g < 4; ++g) {
        const int bb = 4 * sg + g;
        const float c0 = A->in[I_RGH][(size_t)(j * 128 + bb) * DM + cho], c1 = T.A0[g] * c0 + T.B0[g], c2 = T.A1[g] * c1 + T.B1[g];
        const float ci = hh ? c1 : c0;
#pragma unroll
        for (int k = 0; k < 4; ++k) { const int i = 4 * g + k; const float hv = T.hl[i] + T.ac[i] * ci;
            const size_t off = (size_t)(MP + bb * 8 + 4 * hh + k) * DM + cho;
            HG[off] = f2bf(bf2f(GATE[off]) * hv); }
        if (hh == 0) A->out[O_HS + (size_t)(j * 128 + bb) * DM + cho] = c2;
    }
}

#define LDS_BARRIER() do { asm volatile("s_waitcnt lgkmcnt(0)" ::: "memory"); __builtin_amdgcn_s_barrier(); asm volatile("" ::: "memory"); } while (0)
struct G2Pre { float la[16]; u32x4 kv[2], vv[4]; };
DI void g2_prefetch(const float* LAg, const bf16* QKVG, int u, int tid, G2Pre& P) {
    const int h = u & 3, row0 = (u >> 2) * 64, k = tid & 127, tq = tid >> 7;
#pragma unroll
    for (int tt = 0; tt < 16; ++tt) P.la[tt] = LAg[(size_t)(row0 + 16 * tq + tt) * 512 + h * 128 + k];
#pragma unroll
    for (int i = 0; i < 2; ++i) { const int id = tid + 512 * i, t = id >> 4, c8 = id & 15; P.kv[i] = *(const u32x4*)(QKVG + (size_t)(row0 + t) * 3072 + 512 + h * 128 + c8 * 8); }
#pragma unroll
    for (int i = 0; i < 4; ++i) { const int id = tid + 512 * i, t = id >> 5, c8 = id & 31; P.vv[i] = *(const u32x4*)(QKVG + (size_t)(row0 + t) * 3072 + 1024 + h * 256 + c8 * 8); }
}
DI void gla_g2_prompt_all(ArgsP A, LAS unsigned char* lds, int j, int ubeg, int ustep, int uend, int tid0) {
    LAS unsigned char* KE = lds; LAS unsigned char* VI = lds + 17408; LAS float* QT = (LAS float*)(lds + 51200);
    const bf16* QKVG = (const bf16*)(A->ws + WS_QKVG); const float* LAg = (const float*)(A->ws + WS_LA);
    G2Pre P;
    if (ubeg < uend) g2_prefetch(LAg, QKVG, ubeg, tid0, P);
#pragma unroll 1
    for (int u = ubeg; u < uend; u += ustep) {
        int tid = tid0; asm volatile("" : "+v"(tid));
        const int lane = tid & 63, wave = __builtin_amdgcn_readfirstlane(tid >> 6);
        const int h = u & 3, di = ((u >> 7) * 4 + h) * 32 + ((u >> 2) & 31), k = tid & 127, tq = tid >> 7;
#pragma unroll
        for (int i = 0; i < 2; ++i) { const int id = tid + 512 * i, t = id >> 4, c8 = id & 15; *(LAS u32x4*)(KE + t * K128_PITCH + c8 * 16) = P.kv[i]; }
#pragma unroll
        for (int i = 0; i < 4; ++i) { const int id = tid + 512 * i, t = id >> 5, c8 = id & 31; *(LAS u32x4*)(VI + t * KV_PITCH + c8 * 16) = P.vv[i]; }
        float bc[16]; float cum = 0.f;
#pragma unroll
        for (int tt = 0; tt < 16; ++tt) { cum += P.la[tt]; bc[tt] = cum; }
        QT[tq * 128 + k] = cum;
        LDS_BARRIER();
        if (u + ustep < uend) g2_prefetch(LAg, QKVG, u + ustep, tid, P);
        const float q0 = QT[k], q1 = QT[128 + k], q2 = QT[256 + k], q3 = QT[384 + k];
        const float off = tq == 0 ? 0.f : (tq == 1 ? q0 : (tq == 2 ? q0 + q1 : q0 + q1 + q2)), gtot = (q0 + q1) + (q2 + q3);
#pragma unroll
        for (int tt = 0; tt < 16; ++tt) { LAS bf16* kp = (LAS bf16*)(KE + (16 * tq + tt) * K128_PITCH + k * 2); *kp = f2bf(bf2f(*kp) * fexp(gtot - (bc[tt] + off))); }
        if (tq == 0) ((float*)(A->ws + WS_GD))[(size_t)di * 128 + k] = gtot;
        LDS_BARRIER();
        const int kt = wave & 3, vt0 = (wave >> 2) * 4, r = lane & 31, hh = lane >> 5;
        f32x16 z[4];
#pragma unroll
        for (int d = 0; d < 4; ++d) z[d] = zero16();
#pragma unroll
        for (int s = 0; s < 4; ++s) { const int k0 = 16 * s + 8 * hh;
            const bf16x8 af = tr_frag(KE, K128_PITCH, k0, k0 + 4, 32 * kt, lane);
#pragma unroll
            for (int d = 0; d < 4; ++d) { const bf16x8 bv = tr_frag(VI, KV_PITCH, k0, k0 + 4, 32 * (vt0 + d), lane); z[d] = mfma32(af, bv, z[d]); } }
        bf16* DS = (bf16*)(A->ws + WS_DS) + (size_t)di * 32768;
#pragma unroll
        for (int d = 0; d < 4; ++d)
#pragma unroll
            for (int i = 0; i < 16; ++i) DS[(size_t)(32 * kt + crow(i, hh)) * 256 + 32 * (vt0 + d) + r] = f2bf(z[d][i]);
        LDS_BARRIER();
    }
}
DI void gla_sample_unit(ArgsP A, LAS unsigned char* lds, int j, int su, int tid, int wave, int lane) {
    const int b = su >> 2, h = su & 3, row0 = MP + b * 8;
    LAS float* LA = (LAS float*)lds; LAS float* QI = (LAS float*)(lds + 4096); LAS float* KI = (LAS float*)(lds + 8192); LAS float* KEND = (LAS float*)(lds + 12288);
    LAS float* EG = (LAS float*)(lds + 16384); LAS float* ATT = (LAS float*)(lds + 16896); LAS float* OP = (LAS float*)(lds + 17408);
    const bf16* QKVG = (const bf16*)(A->ws + WS_QKVG); const float* LAg = (const float*)(A->ws + WS_LA);
    const int k1 = tid & 127, tq1 = tid >> 7, vq = tid & 63, kg = tid >> 6;
    float la2[2]; bf16 qk[16]; u32x2 vw[8], gw; f32x4 s0[16];
#pragma unroll
    for (int tt = 0; tt < 2; ++tt) la2[tt] = LAg[(size_t)(row0 + 2 * tq1 + tt) * 512 + h * 128 + k1];
    if (tid < 128) {
#pragma unroll
        for (int t = 0; t < 8; ++t) { qk[2 * t] = QKVG[(size_t)(row0 + t) * 3072 + h * 128 + k1]; qk[2 * t + 1] = QKVG[(size_t)(row0 + t) * 3072 + 512 + h * 128 + k1]; } }
#pragma unroll
    for (int s = 0; s < 8; ++s) vw[s] = *(const u32x2*)(QKVG + (size_t)(row0 + s) * 3072 + 1024 + h * 256 + 4 * vq);
    gw = *(const u32x2*)(QKVG + (size_t)(row0 + (tid >> 6)) * 3072 + 2048 + h * 256 + 4 * vq);
    const float* S0 = A->in[I_GLAS] + ((size_t)((j * 128 + b) * 4 + h) * 128 + 16 * kg) * 256 + 4 * vq;
    float* SO = A->out + O_SS + ((size_t)((j * 128 + b) * 4 + h) * 128 + 16 * kg) * 256 + 4 * vq;
#pragma unroll
    for (int kk = 0; kk < 16; ++kk) s0[kk] = __builtin_nontemporal_load((const f32x4*)(S0 + (size_t)kk * 256));
#pragma unroll
    for (int tt = 0; tt < 2; ++tt) LA[(2 * tq1 + tt) * 128 + k1] = la2[tt];
    LDS_BARRIER();
    if (tid < 128) { const int k = tid; float bcv[8]; float cum = 0.f;
#pragma unroll
        for (int t = 0; t < 8; ++t) { cum += LA[t * 128 + k]; bcv[t] = cum; }
#pragma unroll
        for (int t = 0; t < 8; ++t) { const float qv = bf2f(qk[2 * t]), kv = bf2f(qk[2 * t + 1]);
            QI[t * 128 + k] = qv * fexp(bcv[t]); KI[t * 128 + k] = kv * fexp(-bcv[t]); KEND[t * 128 + k] = kv * fexp(cum - bcv[t]); }
        EG[k] = fexp(cum); }
    LDS_BARRIER();
    if (tid < 64) { const int t = tid >> 3, s = tid & 7; float a = 0.f;
        if (s <= t) { for (int k = 0; k < 128; ++k) a += QI[t * 128 + k] * KI[s * 128 + k]; }
        ATT[t * 8 + s] = a; }
    LDS_BARRIER();
    {   f32x4 v[8], o[8];
#pragma unroll
        for (int s = 0; s < 8; ++s) { v[s] = (f32x4){bf_lo(vw[s].x), bf_hi(vw[s].x), bf_lo(vw[s].y), bf_hi(vw[s].y)}; o[s] = (f32x4){0.f, 0.f, 0.f, 0.f}; }
#pragma unroll
        for (int kk = 0; kk < 16; ++kk) { const int k = 16 * kg + kk; f32x4 sn = s0[kk] * EG[k];
#pragma unroll
            for (int s = 0; s < 8; ++s) { sn += v[s] * KEND[s * 128 + k]; o[s] += s0[kk] * QI[s * 128 + k]; }
            __builtin_nontemporal_store(sn, (f32x4*)(SO + (size_t)kk * 256)); }
        if (kg == 0) {
#pragma unroll
            for (int t = 0; t < 8; ++t)
#pragma unroll
                for (int s = 0; s < 8; ++s) if (s <= t) o[t] += v[s] * ATT[t * 8 + s]; }
#pragma unroll
        for (int t = 0; t < 8; ++t) *(LAS f32x4*)(OP + (kg * 8 + t) * 256 + 4 * vq) = o[t];
    }
    LDS_BARRIER();
    {   const int t = tid >> 6;
        f32x4 o = (f32x4){0.f, 0.f, 0.f, 0.f};
#pragma unroll
        for (int kg2 = 0; kg2 < 8; ++kg2) o += *(const LAS f32x4*)(OP + (kg2 * 8 + t) * 256 + 4 * vq);
        float sq = (o[0] * o[0] + o[1] * o[1]) + (o[2] * o[2] + o[3] * o[3]); sq = wave_sum(sq);
        const float rstd = __builtin_amdgcn_rsqf(sq * (1.f / 256.f) + EPSN);
        u32x2 w; w.x = pk2(o[0] * rstd * bf_lo(gw.x), o[1] * rstd * bf_hi(gw.x)); w.y = pk2(o[2] * rstd * bf_lo(gw.y), o[3] * rstd * bf_hi(gw.y));
        *(u32x2*)((bf16*)(A->ws + WS_A3) + (size_t)(row0 + t) * DM + h * 256 + 4 * vq) = w;
    }
    LDS_BARRIER();
}
DI void gla_g3(ArgsP A, int j, int ebeg, int estep, int eend) {
    const bf16* DS = (const bf16*)(A->ws + WS_DS); bf16* SC = (bf16*)(A->ws + WS_SC); const float* GD = (const float*)(A->ws + WS_GD);
    for (int e = ebeg; e < eend; e += estep) {
        const int vq = e & 63, k = (e >> 6) & 127, bh = e >> 13;
        const size_t base = (size_t)bh * 32 * 32768 + (size_t)k * 256 + 4 * vq;
        f32x4 S = (f32x4){0.f, 0.f, 0.f, 0.f};
#pragma unroll 1
        for (int c8 = 0; c8 < 32; c8 += 8) {
            u32x2 d[8]; float g[8];
#pragma unroll
            for (int i = 0; i < 8; ++i) { d[i] = *(const u32x2*)(DS + base + (size_t)(c8 + i) * 32768); g[i] = GD[(size_t)(bh * 32 + c8 + i) * 128 + k]; }
#pragma unroll
            for (int i = 0; i < 8; ++i) { u32x2 w; w.x = pk2(S[0], S[1]); w.y = pk2(S[2], S[3]); *(u32x2*)(SC + base + (size_t)(c8 + i) * 32768) = w;
                const float eg = fexp(g[i]); S = S * eg + (f32x4){bf_lo(d[i].x), bf_hi(d[i].x), bf_lo(d[i].y), bf_hi(d[i].y)}; }
        }
        *(f32x4*)(A->out + O_SP + (size_t)(j * 32 + bh) * 32768 + (size_t)k * 256 + 4 * vq) = S;
    }
}
struct G4Pre { float la[16]; u32x4 qv[2], kv[2], vv[4], sc[8]; };
DI void g4_prefetch(const float* LAg, const bf16* QKVG, const bf16* SCg, int u, int tid, G4Pre& P) {
    const int h = u & 3, row0 = (u >> 2) * 64, di = ((u >> 7) * 4 + h) * 32 + ((u >> 2) & 31), k = tid & 127, tq = tid >> 7;
#pragma unroll
    for (int tt = 0; tt < 16; ++tt) P.la[tt] = LAg[(size_t)(row0 + 16 * tq + tt) * 512 + h * 128 + k];
#pragma unroll
    for (int i = 0; i < 2; ++i) { const int id = tid + 512 * i, t = id >> 4, c8 = id & 15; const bf16* rp = QKVG + (size_t)(row0 + t) * 3072 + h * 128 + c8 * 8; P.qv[i] = *(const u32x4*)rp; P.kv[i] = *(const u32x4*)(rp + 512); }
#pragma unroll
    for (int i = 0; i < 4; ++i) { const int id = tid + 512 * i, t = id >> 5, c8 = id & 31; P.vv[i] = *(const u32x4*)(QKVG + (size_t)(row0 + t) * 3072 + 1024 + h * 256 + c8 * 8); }
#pragma unroll
    for (int i = 0; i < 8; ++i) { const int id = tid + 512 * i; P.sc[i] = *(const u32x4*)(SCg + (size_t)di * 32768 + (size_t)id * 8); }
}
DI void gla_g4_prompt_all(ArgsP A, LAS unsigned char* lds, int j, int ubeg, int ustep, int uend, int tid0) {
    LAS unsigned char* QIm = lds; LAS unsigned char* KIm = lds + 17408; LAS unsigned char* VI = lds + 34816; LAS unsigned char* SI = lds + 68608;
    LAS float* RED = (LAS float*)(lds + 136192); LAS float* QT = (LAS float*)(lds + 137216);
    const bf16* QKVG = (const bf16*)(A->ws + WS_QKVG); const float* LAg = (const float*)(A->ws + WS_LA); const bf16* SCg = (const bf16*)(A->ws + WS_SC);
    bf16* OG = (bf16*)(A->ws + WS_A3);
    G4Pre P;
    if (ubeg < uend) g4_prefetch(LAg, QKVG, SCg, ubeg, tid0, P);
#pragma unroll 1
    for (int u = ubeg; u < uend; u += ustep) {
        int tid = tid0; asm volatile("" : "+v"(tid));
        const int lane = tid & 63, wave = __builtin_amdgcn_readfirstlane(tid >> 6);
        const int h = u & 3, row0 = (u >> 2) * 64, k = tid & 127, tq = tid >> 7;
#pragma unroll
        for (int i = 0; i < 2; ++i) { const int id = tid + 512 * i, t = id >> 4, c8 = id & 15; *(LAS u32x4*)(QIm + t * K128_PITCH + c8 * 16) = P.qv[i]; *(LAS u32x4*)(KIm + t * K128_PITCH + c8 * 16) = P.kv[i]; }
#pragma unroll
        for (int i = 0; i < 4; ++i) { const int id = tid + 512 * i, t = id >> 5, c8 = id & 31; *(LAS u32x4*)(VI + t * KV_PITCH + c8 * 16) = P.vv[i]; }
#pragma unroll
        for (int i = 0; i < 8; ++i) { const int id = tid + 512 * i, kr = id >> 5, c8 = id & 31; *(LAS u32x4*)(SI + kr * KV_PITCH + c8 * 16) = P.sc[i]; }
        float bc[16]; float cum = 0.f;
#pragma unroll
        for (int tt = 0; tt < 16; ++tt) { cum += P.la[tt]; bc[tt] = cum; }
        QT[tq * 128 + k] = cum;
        LDS_BARRIER();
        if (u + ustep < uend) g4_prefetch(LAg, QKVG, SCg, u + ustep, tid, P);
        {   const float q0 = QT[k], q1 = QT[128 + k], q2 = QT[256 + k];
            const float off = tq == 0 ? 0.f : (tq == 1 ? q0 : (tq == 2 ? q0 + q1 : q0 + q1 + q2));
#pragma unroll
            for (int tt = 0; tt < 16; ++tt) { const float e = fexp(bc[tt] + off), ei = frcp(e);
                LAS bf16* qp = (LAS bf16*)(QIm + (16 * tq + tt) * K128_PITCH + k * 2); LAS bf16* kp = (LAS bf16*)(KIm + (16 * tq + tt) * K128_PITCH + k * 2);
                *qp = f2bf(bf2f(*qp) * e); *kp = f2bf(bf2f(*kp) * ei); }
        }
        LDS_BARRIER();
        u32x4 sgv[4];
#pragma unroll
        for (int i = 0; i < 4; ++i) { const int id = tid + 512 * i, t = id >> 5, c8 = id & 31; sgv[i] = *(const u32x4*)(QKVG + (size_t)(row0 + t) * 3072 + 2048 + h * 256 + c8 * 8); }
        const int tt2 = wave >> 2, vt0 = (wave & 3) * 2, r = lane & 31, hh = lane >> 5;
        f32x16 z[2]; z[0] = zero16(); z[1] = zero16();
#pragma unroll
        for (int st = 0; st < 2; ++st) {
            if (st <= tt2) {
                f32x16 x = zero16();
#pragma unroll
                for (int kk = 0; kk < 8; ++kk) { const bf16x8 af = *(const LAS bf16x8*)(KIm + (32 * st + r) * K128_PITCH + (16 * kk + 8 * hh) * 2), bq = *(const LAS bf16x8*)(QIm + (32 * tt2 + r) * K128_PITCH + (16 * kk + 8 * hh) * 2); x = mfma32(af, bq, x); }
                if (st == tt2) {
#pragma unroll
                    for (int i = 0; i < 16; ++i) if (crow(i, hh) > r) x[i] = 0.f; }
#pragma unroll
                for (int ss = 0; ss < 2; ++ss) { const bf16x8 pf = pack_step(x, ss, 1.0f); const int k0 = 32 * st + 16 * ss + 4 * hh;
#pragma unroll
                    for (int d = 0; d < 2; ++d) { const bf16x8 bv = tr_frag(VI, KV_PITCH, k0, k0 + 8, 32 * (vt0 + d), lane); z[d] = mfma32(pf, bv, z[d]); } }
            }
        }
#pragma unroll
        for (int kk = 0; kk < 8; ++kk) { const bf16x8 af = *(const LAS bf16x8*)(QIm + (32 * tt2 + r) * K128_PITCH + (16 * kk + 8 * hh) * 2); const int k0 = 16 * kk + 8 * hh;
#pragma unroll
            for (int d = 0; d < 2; ++d) { const bf16x8 bv = tr_frag(SI, KV_PITCH, k0, k0 + 4, 32 * (vt0 + d), lane); z[d] = mfma32(af, bv, z[d]); } }
#pragma unroll
        for (int i = 0; i < 16; ++i) { float sq = z[0][i] * z[0][i] + z[1][i] * z[1][i];
            sq = xsum16(xsum_row16(sq));
            if (r == 0) RED[(32 * tt2 + crow(i, hh)) * 4 + (wave & 3)] = sq; }
        LDS_BARRIER();
#pragma unroll
        for (int i = 0; i < 16; ++i) { const int t = 32 * tt2 + crow(i, hh); const f32x4 rq = *(const LAS f32x4*)(RED + t * 4);
            const float rstd = __builtin_amdgcn_rsqf(((rq[0] + rq[1]) + (rq[2] + rq[3])) * (1.f / 256.f) + EPSN);
#pragma unroll
            for (int d = 0; d < 2; ++d) *(LAS bf16*)(SI + t * KV_PITCH + (32 * (vt0 + d) + r) * 2) = f2bf(z[d][i] * rstd); }
        LDS_BARRIER();
#pragma unroll
        for (int i = 0; i < 4; ++i) { const int id = tid + 512 * i, t = id >> 5, c8 = id & 31; const u32x4 o = *(const LAS u32x4*)(SI + t * KV_PITCH + c8 * 16), g = sgv[i];
            u32x4 w; w.x = pk2(bf_lo(o.x) * bf_lo(g.x), bf_hi(o.x) * bf_hi(g.x)); w.y = pk2(bf_lo(o.y) * bf_lo(g.y), bf_hi(o.y) * bf_hi(g.y));
            w.z = pk2(bf_lo(o.z) * bf_lo(g.z), bf_hi(o.z) * bf_hi(g.z)); w.w = pk2(bf_lo(o.w) * bf_lo(g.w), bf_hi(o.w) * bf_hi(g.w));
            *(u32x4*)(OG + (size_t)(row0 + t) * DM + h * 256 + c8 * 8) = w; }
        LDS_BARRIER();
    }
}

#define UNIT_BEGIN int tid_u = tid; asm volatile("" : "+v"(tid_u)); const int lane_u = tid_u & 63, wave_u = __builtin_amdgcn_readfirstlane(tid_u >> 6); (void)lane_u; (void)wave_u;
#define PHASE_BEGIN ArgsP A = A0; int tid = tid0, bid = bid0; asm volatile("" : "+s"(A), "+v"(tid), "+s"(bid)); const int lane = tid & 63, wave = __builtin_amdgcn_readfirstlane(tid >> 6); \
    unsigned char* ws = A->ws; const int grp = bid & 7, rank = bid >> 3; (void)lane; (void)wave; (void)ws; (void)grp; (void)rank;
#define RS_TABLE() do { LAS float* rsl_ = (LAS float*)(lds + 131072); if (tid < 256) { const float* sp_ = (const float*)(ws + WS_SSQ) + (size_t)(256 * (8 * grp + (rank & 7)) + tid) * 32; float s_ = 0.f; \
        _Pragma("unroll") for (int q_ = 0; q_ < 8; ++q_) { const f32x4 v_ = *(const f32x4*)(sp_ + 4 * q_); s_ += (v_[0] + v_[1]) + (v_[2] + v_[3]); } rsl_[tid] = __builtin_amdgcn_rsqf(s_ * (1.f / 1024.f) + EPSN); } __syncthreads(); } while (0)
#define GRP_BAR() do { ArgsP Ab_ = A0; int bb_ = bid0; asm volatile("" : "+s"(Ab_), "+s"(bb_)); XcdBarrier gb_; gb_.bar = (unsigned*)(Ab_->ws + WS_CTL) + CW_BAR + (1 + (bb_ & 7)) * XCD_BAR_WORDS; \
    gb_.x = xb_xcc_id(); gb_.st = (volatile LAS unsigned*)(lds + MISC_OFF) + 2; grp_barrier(gb_, 32u); } while (0)
constexpr int GRID = 256;
__global__ void __launch_bounds__(NTHREADS, 2) hybrid_fwd(Args Aval) {
    extern __shared__ __attribute__((aligned(16))) unsigned char lds_raw[];
    LAS unsigned char* lds = (LAS unsigned char*)lds_raw;
    const ArgsP A0 = (ArgsP)__builtin_amdgcn_kernarg_segment_ptr();
    const int tid0 = threadIdx.x, bid0 = blockIdx.x;
    XcdBarrier bar;
    {   PHASE_BEGIN
        volatile LAS unsigned* MISC = (volatile LAS unsigned*)(lds + MISC_OFF);
        if (tid < 16) MISC[tid] = 0u;
        __syncthreads();
        bar = xcd_barrier_post((unsigned*)(ws + WS_CTL) + CW_BAR, MISC);
        (void)xcd_barrier_post((unsigned*)(ws + WS_CTL) + CW_BAR + (1 + grp) * XCD_BAR_WORDS, MISC + 2);
        p0_prologue(A, lds, (grp * 32 + rank) * NWAVES + wave, GRID * NWAVES, wave, lane);
    }
    xcd_barrier(bar);
#define PKV_PHASE(slot_) do { if ((((bid0 & 7) >> 1) & 3) == (slot_)) { PHASE_BEGIN \
        pg8::Gemm g{(const pg8::bf16_t*)(ws + WS_MN), (const pg8::bf16_t*)(ws + WS_WKV), 2048, 8192, DM}; pg8::GroupOrder S{1, 32, grp, rank}; \
        pg8::BigEpi<pg8::MemKVR8, slot_> E{{A->out + O_MK, A->out + O_MV, (pg8::bf16_t*)(ws + WS_KPB), (pg8::bf16_t*)(ws + WS_VPB), nullptr}}; \
        pg8::gemm_phase<pg8::BigEpi<pg8::MemKVR8, slot_>, pg8::GroupOrder, true, true>(lds, g, S, E, tid); } } while (0)
    PKV_PHASE(0);

#pragma unroll 1
    for (int l = 0; l < 4; ++l) {
        const int j = l >> 1;
        if ((l & 1) == 0) {
            {   PHASE_BEGIN
                const pg8::bf16_t* W = (const pg8::bf16_t*)(ws + WS_RGWIN) + (size_t)j * 2048 * DM;
                pg8::Gemm g{(const pg8::bf16_t*)(ws + WS_XB), W, MP, 2048, DM}; pg8::GroupOrder S{8, 8, grp, rank};
                pg8::BigEpi<pg8::RgInR8> E{{(pg8::bf16_t*)(ws + WS_A1), (pg8::bf16_t*)(ws + WS_A2), (const float*)(ws + WS_SSQ), A->out + O_CP + (size_t)j * 8 * 3 * DM, A->out + O_CS + (size_t)j * 128 * 3 * DM, (const LAS float*)(lds + 131072)}};
                RS_TABLE();
                pg8::gemm_phase<pg8::BigEpi<pg8::RgInR8>, pg8::GroupOrder, true, true>(lds, g, S, E, tid);
                small_gemm<2, 1, 5, 1>(lds, (const bf16*)(ws + WS_XB), W, DM, MP + 128 * grp + 64 * (rank & 1), 128 * (rank >> 1), E.e, tid, wave, lane);
            }
            GRP_BAR();
            if (l == 0) PKV_PHASE(1);
            {   PHASE_BEGIN
                { UNIT_BEGIN rg_prompt_unit(A, lds, j, grp, rank >> 1, rank & 1, wave_u, lane_u); __syncthreads(); }
                if (rank < 16) { UNIT_BEGIN const int wl = rank * 8 + wave_u; rg_sample_unit(A, lds, j, ((4 * grp + (wl >> 5)) << 5) | (wl & 31), wave_u, lane_u); }
            }
            GRP_BAR();
            if (l == 0) PKV_PHASE(2);
        } else {
            {   PHASE_BEGIN
                const pg8::bf16_t* W = (const pg8::bf16_t*)(ws + WS_GLAWIN) + (size_t)j * GINP * DM;
                pg8::Gemm g{(const pg8::bf16_t*)(ws + WS_XB), W, MP, 3072, DM}; pg8::GroupOrder S{8, 12, grp, rank};
                pg8::BigEpi<pg8::GlaInR8> E{{(pg8::bf16_t*)(ws + WS_QKVG), (const float*)(ws + WS_SSQ), (const LAS float*)(lds + 131072)}};
                RS_TABLE();
                pg8::gemm_phase<pg8::BigEpi<pg8::GlaInR8>, pg8::GroupOrder, true, true>(lds, g, S, E, tid);
                if (rank < 24) small_gemm<2, 2, 3, 1>(lds, (const bf16*)(ws + WS_XB), W, DM, MP + 128 * grp + 64 * (rank & 1), 256 * (rank >> 1), E.e, tid, wave, lane);
                {   const int f = rank * NWAVES + wave;
                    if (f < 136) la_unit((const bf16*)(ws + WS_XB), W + (size_t)3072 * DM, (const float*)(ws + WS_SSQ), A->in[I_GLAWA2] + (size_t)j * 16 * 512, A->in[I_GLABA] + j * 512, (float*)(ws + WS_LA), (LAS float*)(lds + wave * 1024),
                                         f < 128 ? 2048 * grp + 16 * f : MP + 128 * grp + 16 * (f - 128), lane); }
            }
            GRP_BAR();
            {   PHASE_BEGIN
                if (grp & 1) { for (int su = 64 * grp + rank; su < 64 * grp + 64; su += 32) { UNIT_BEGIN gla_sample_unit(A, lds, j, su, tid_u, wave_u, lane_u); } }
                gla_g2_prompt_all(A, lds, j, 128 * grp + rank, 32, 128 * grp + 128, tid);
                if (!(grp & 1)) { for (int su = 64 * grp + rank; su < 64 * grp + 64; su += 32) { UNIT_BEGIN gla_sample_unit(A, lds, j, su, tid_u, wave_u, lane_u); } }
            }
            GRP_BAR();
            {   PHASE_BEGIN
                gla_g3(A, j, 32768 * grp + rank * NTHREADS + tid, 32 * NTHREADS, 32768 * grp + 32768);
            }
            GRP_BAR();
            {   PHASE_BEGIN
                gla_g4_prompt_all(A, lds, j, 128 * grp + rank, 32, 128 * grp + 128, tid);
            }
            GRP_BAR();
        }
        {   PHASE_BEGIN
            const pg8::bf16_t* W = (l & 1) ? (const pg8::bf16_t*)(ws + WS_GLAWOUT) + (size_t)j * DM * DM : (const pg8::bf16_t*)(ws + WS_RGWOUT) + (size_t)j * DM * DM;
            pg8::Gemm g{(const pg8::bf16_t*)(ws + WS_A3), W, MP, DM, DM}; pg8::GroupOrder S{8, 4, grp, rank};
            pg8::BigEpi<pg8::XupdR8> E{{(pg8::bf16_t*)(ws + WS_XB), (float*)(ws + WS_SSQ), 1.f}};
            pg8::gemm_phase<pg8::BigEpi<pg8::XupdR8>, pg8::GroupOrder, true, true>(lds, g, S, E, tid);
            small_gemm<1, 1, 4, 2>(lds, (const bf16*)(ws + WS_A3), W, DM, MP + 128 * grp + 64 * (rank & 1), 64 * (rank >> 1), E.e, tid, wave, lane);
        }
        GRP_BAR();
        if (l == 0) PKV_PHASE(3);
        {   PHASE_BEGIN
            const pg8::bf16_t* W = (const pg8::bf16_t*)(ws + WS_WQ) + (size_t)l * DM * DM;
            pg8::Gemm g{(const pg8::bf16_t*)(ws + WS_XB), W, MP, DM, DM}; pg8::GroupOrder S{8, 4, grp, rank};
            pg8::BigEpi<pg8::RsBf16R8<0>> E{{(pg8::bf16_t*)(ws + WS_A1), DM, (const float*)(ws + WS_SSQ), (const LAS float*)(lds + 131072)}};
            RS_TABLE();
            pg8::gemm_phase<pg8::BigEpi<pg8::RsBf16R8<0>>, pg8::GroupOrder, true, true>(lds, g, S, E, tid);
            small_gemm<1, 1, 4, 2>(lds, (const bf16*)(ws + WS_XB), W, DM, MP + 128 * grp + 64 * (rank & 1), 64 * (rank >> 1), E.e, tid, wave, lane);
            if (!(grp & 1)) attn_stage_kv(lds, (const bf16*)(ws + WS_KPB) + (size_t)l * 2048 * DM, grp, rank >> 3, tid);
        }
        GRP_BAR();
        {   PHASE_BEGIN
            if (grp & 1) { UNIT_BEGIN attn_sample_unit(lds, (const bf16*)(ws + WS_A1), A->in[I_CK] + (size_t)l * 128 * 256 * 1024, A->in[I_CV] + (size_t)l * 128 * 256 * 1024, (bf16*)(ws + WS_A2), 32 * grp + rank, tid_u, wave_u, lane_u); __syncthreads(); }
            { UNIT_BEGIN attn_prompt_unit(lds, (const bf16*)(ws + WS_A1), (const bf16*)(ws + WS_KPB) + (size_t)l * 2048 * DM, (const bf16*)(ws + WS_VPB) + (size_t)l * 2048 * DM, (bf16*)(ws + WS_A2), grp, rank >> 3, rank & 7, tid_u, wave_u, lane_u, (grp & 1) == 0); __syncthreads(); }
            if (!(grp & 1)) { UNIT_BEGIN attn_sample_unit(lds, (const bf16*)(ws + WS_A1), A->in[I_CK] + (size_t)l * 128 * 256 * 1024, A->in[I_CV] + (size_t)l * 128 * 256 * 1024, (bf16*)(ws + WS_A2), 32 * grp + rank, tid_u, wave_u, lane_u); __syncthreads(); }
        }
        GRP_BAR();
        {   PHASE_BEGIN
            const pg8::bf16_t* W = (const pg8::bf16_t*)(ws + WS_WO) + (size_t)l * DM * DM;
            pg8::Gemm g{(const pg8::bf16_t*)(ws + WS_A2), W, MP, DM, DM}; pg8::GroupOrder S{8, 4, grp, rank};
            pg8::BigEpi<pg8::XupdR8> E{{(pg8::bf16_t*)(ws + WS_XB), (float*)(ws + WS_SSQ), 1.f}};
            pg8::gemm_phase<pg8::BigEpi<pg8::XupdR8>, pg8::GroupOrder, true, true>(lds, g, S, E, tid);
            small_gemm<1, 1, 4, 2>(lds, (const bf16*)(ws + WS_A2), W, DM, MP + 128 * grp + 64 * (rank & 1), 64 * (rank >> 1), E.e, tid, wave, lane);
        }
        GRP_BAR();
        {   PHASE_BEGIN
            const pg8::bf16_t* W = (const pg8::bf16_t*)(ws + WS_W1) + (size_t)l * DFF * DM;
            pg8::Gemm g{(const pg8::bf16_t*)(ws + WS_XB), W, MP, DFF, DM}; pg8::GroupOrder S{8, 16, grp, rank, true};
            pg8::BigEpi<pg8::RsBf16R8<1>> E{{(pg8::bf16_t*)(ws + WS_H1), DFF, (const float*)(ws + WS_SSQ), (const LAS float*)(lds + 131072)}};
            RS_TABLE();
            pg8::gemm_phase<pg8::BigEpi<pg8::RsBf16R8<1>>, pg8::GroupOrder, true, true>(lds, g, S, E, tid);
            small_gemm<2, 2, 3, 1>(lds, (const bf16*)(ws + WS_XB), W, DM, MP + 128 * grp + 64 * (rank & 1), 256 * (rank >> 1), E.e, tid, wave, lane);
        }
        GRP_BAR();
        {   PHASE_BEGIN
            const pg8::bf16_t* W = (const pg8::bf16_t*)(ws + WS_W2) + (size_t)l * DM * DFF;
            pg8::Gemm g{(const pg8::bf16_t*)(ws + WS_H1), W, MP, DM, DFF}; pg8::GroupOrder S{8, 4, grp, rank};
            pg8::BigEpi<pg8::XupdR8> E{{(pg8::bf16_t*)(ws + WS_XB), (float*)(ws + WS_SSQ), 1.f}};
            pg8::gemm_phase<pg8::BigEpi<pg8::XupdR8>, pg8::GroupOrder, true, true>(lds, g, S, E, tid);
            small_gemm<1, 1, 4, 2>(lds, (const bf16*)(ws + WS_H1), W, DFF, MP + 128 * grp + 64 * (rank & 1), 64 * (rank >> 1), E.e, tid, wave, lane);
        }
        GRP_BAR();
    }
    {   PHASE_BEGIN
        const bf16* XBp = (const bf16*)(ws + WS_XB); const float* SS = (const float*)(ws + WS_SSQ);
        for (int i = rank * NWAVES + wave; i < 2048 + 128; i += 32 * NWAVES) {
            const int m = i < 2048 ? 2048 * grp + i : MP + 128 * grp + (i - 2048);
            float s = SS[(size_t)m * 32 + (lane & 31)];
            s = xsum16(xsum_row16(s));
            const float rstd = __builtin_amdgcn_rsqf(s * (1.f / 1024.f) + EPSN);
#pragma unroll
            for (int jq = 0; jq < 2; ++jq) { const u32x4 w = ((const u32x4*)(XBp + (size_t)m * DM))[64 * jq + lane]; const float* gp = A->in[I_NFIN] + 8 * (64 * jq + lane); const f32x4 g0 = *(const f32x4*)gp, g1 = *(const f32x4*)(gp + 4);
                float* op = A->out + (size_t)m * DM + 8 * (64 * jq + lane);
                __builtin_nontemporal_store((f32x4){bf_lo(w.x), bf_hi(w.x), bf_lo(w.y), bf_hi(w.y)} * rstd * g0, (f32x4*)op); __builtin_nontemporal_store((f32x4){bf_lo(w.z), bf_hi(w.z), bf_lo(w.w), bf_hi(w.w)} * rstd * g1, (f32x4*)(op + 4)); }
        }
    }
}

extern "C" void kernel_launch(void* const* d_in, const int* in_sizes, int n_in, void* d_out, int out_size, void* d_ws, size_t ws_size, hipStream_t stream) {
    static int grid = 0;
    if (grid == 0) {
        if (n_in != N_IN || (size_t)out_size != O_END || ws_size < WS_END) { fprintf(stderr, "kernel_launch: unexpected shapes (n_in %d, out %d, ws %zu); nothing launched\n", n_in, out_size, ws_size); grid = -1; return; }
        int dev = 0, cus = 0, per_cu = 0;
        if (hipGetDevice(&dev) != hipSuccess || hipDeviceGetAttribute(&cus, hipDeviceAttributeMultiprocessorCount, dev) != hipSuccess) { grid = -1; return; }
        if (hipFuncSetAttribute((const void*)hybrid_fwd, hipFuncAttributeMaxDynamicSharedMemorySize, LDS_BYTES) != hipSuccess) { fprintf(stderr, "kernel_launch: hipFuncSetAttribute failed\n"); grid = -1; return; }
        if (hipOccupancyMaxActiveBlocksPerMultiprocessor(&per_cu, (const void*)hybrid_fwd, NTHREADS, LDS_BYTES) != hipSuccess || per_cu < 1) { fprintf(stderr, "kernel_launch: occupancy query reports %d workgroups per CU\n", per_cu); }
        (void)hipGetLastError();
        if (cus < GRID) { fprintf(stderr, "kernel_launch: built for %d resident workgroups (one per CU), the device has %d CUs; nothing launched\n", GRID, cus); grid = -1; return; }
        grid = GRID;
    }
    if (grid < 0) return;
    if (hipMemsetAsync((char*)d_ws + WS_CTL, 0, CTL_ZERO_BYTES, stream) != hipSuccess) return;
    Args a{};
    for (int i = 0; i < N_IN; ++i) a.in[i] = (const float*)d_in[i];
    a.out = (float*)d_out; a.ws = (unsigned char*)d_ws;
    hipLaunchKernelGGL(hybrid_fwd, dim3(grid), dim3(NTHREADS), LDS_BYTES, stream, a);
}
```

```cpp
#include <hip/hip_runtime.h>
#include <cstdio>
#include <cstdint>

#define DI __device__ __forceinline__
#define GAS __attribute__((address_space(1)))
#define LAS __attribute__((address_space(3)))
typedef unsigned short bf16;
typedef short bf16x8 __attribute__((ext_vector_type(8)));
typedef short s16x4 __attribute__((ext_vector_type(4)));
typedef float f32x2 __attribute__((ext_vector_type(2)));
typedef float f32x4 __attribute__((ext_vector_type(4)));
typedef float f32x16 __attribute__((ext_vector_type(16)));
typedef unsigned u32x2 __attribute__((ext_vector_type(2)));
typedef unsigned u32x4 __attribute__((ext_vector_type(4)));
typedef __bf16 bf2_t __attribute__((ext_vector_type(2)));

DI unsigned pk2(float lo, float hi) { f32x2 v = {lo, hi}; return __builtin_bit_cast(unsigned, __builtin_convertvector(v, bf2_t)); }
DI float bf_lo(unsigned u) { return __uint_as_float(u << 16); }
DI float bf_hi(unsigned u) { return __uint_as_float(u & 0xffff0000u); }
DI float bf2f(bf16 b) { return __uint_as_float(((unsigned)b) << 16); }
DI bf16 f2bf(float f) { return (bf16)(pk2(f, 0.f) & 0xffffu); }
DI float fexp(float x) { return __builtin_amdgcn_exp2f(x * 1.4426950408889634f); }
DI float frcp(float x) { return __builtin_amdgcn_rcpf(x); }
DI float fsigmoid(float x) { return frcp(1.0f + fexp(-x)); }
typedef unsigned u32x2p __attribute__((ext_vector_type(2)));
DI float xsum16(float v) { const unsigned u = __float_as_uint(v); const u32x2p r = __builtin_amdgcn_permlane16_swap(u, u, false, false); return __uint_as_float(r[0]) + __uint_as_float(r[1]); }
DI float xsum32(float v) { const unsigned u = __float_as_uint(v); const u32x2p r = __builtin_amdgcn_permlane32_swap(u, u, false, false); return __uint_as_float(r[0]) + __uint_as_float(r[1]); }
DI float xmax32(float v) { const unsigned u = __float_as_uint(v); const u32x2p r = __builtin_amdgcn_permlane32_swap(u, u, false, false); return fmaxf(__uint_as_float(r[0]), __uint_as_float(r[1])); }
DI void halves32(float v, float& lo, float& hi) { const unsigned u = __float_as_uint(v); const u32x2p r = __builtin_amdgcn_permlane32_swap(u, u, false, false); lo = __uint_as_float(r[0]); hi = __uint_as_float(r[1]); }
DI float xsum_row16(float v) {
    v += __uint_as_float(__builtin_amdgcn_mov_dpp(__float_as_uint(v), 0xB1, 0xF, 0xF, true));
    v += __uint_as_float(__builtin_amdgcn_mov_dpp(__float_as_uint(v), 0x4E, 0xF, 0xF, true));
    v += __uint_as_float(__builtin_amdgcn_mov_dpp(__float_as_uint(v), 0x141, 0xF, 0xF, true));
    v += __uint_as_float(__builtin_amdgcn_mov_dpp(__float_as_uint(v), 0x140, 0xF, 0xF, true));
    return v;
}
DI float wave_sum(float v) { return xsum32(xsum16(xsum_row16(v))); }
#define LDS_WAIT() asm volatile("s_waitcnt lgkmcnt(0)" ::: "memory")
#define VM_WAIT() asm volatile("s_waitcnt vmcnt(0)" ::: "memory")

namespace pg8 {
#define PG8_LAS __attribute__((address_space(3)))
typedef unsigned short bf16_t;
typedef short bf16x8 __attribute__((ext_vector_type(8)));
typedef float f32x4 __attribute__((ext_vector_type(4)));
typedef unsigned u32x4 __attribute__((ext_vector_type(4)));
constexpr int BM = 256, BK = 64, HALF = 128, HTB = HALF * BK * 2  , STAGE_BYTES = 8 * HTB, NXCD = 8, WGM = 8;

__host__ __device__ __forceinline__ int lds_byte(int r, int c) { const int st = (r >> 4) * 2 + (c >> 5), rr = r & 15, cc = c & 31, ob = rr * 64 + cc * 2; return st * 1024 + (ob ^ (((ob >> 9) & 1) << 5)); }
__host__ __device__ __forceinline__ void stage_rc(int b, int& R, int& C) { const int st = b / 1024, sb = b % 1024, swz = sb ^ (((sb >> 9) & 1) << 5); R = (st >> 1) * 16 + swz / 64; C = (st & 1) * 32 + (swz % 64) / 2; }
__host__ __device__ __forceinline__ int perm32(int rho) { const int n = rho >> 4, i = rho & 15; return 8 * (i >> 2) + 4 * n + (i & 3); }

struct Unit { int pm, pn; };
struct Gemm { const bf16_t* A; const bf16_t* Bt; int M, N, K; };

struct StaticOrder {
    int nM, nN, nwg, G, c;
    __host__ __device__ void init(int M, int N, int G_, int c_) { nM = M / BM; nN = N / BM; nwg = nM * nN; G = G_; c = c_; }
    __host__ __device__ bool next(int i, Unit& u) const {
        const long L = (long)i * G + c; if (L >= nwg) return false;
        int wgid = (int)L; { const int q = nwg / NXCD, r = nwg % NXCD, xcd = wgid % NXCD, off = wgid / NXCD; wgid = (xcd < r ? xcd * (q + 1) : r * (q + 1) + (xcd - r) * q) + off; }
        const int nig = WGM * nN, gid = wgid / nig, fm = gid * WGM, gsz = (nM - fm) < WGM ? (nM - fm) : WGM;
        u.pm = fm + ((wgid % nig) % gsz); u.pn = (wgid % nig) / gsz; return true;
    }
    __device__ __forceinline__ void a_ready(const Unit&) const {}
    __device__ __forceinline__ void done(const Unit&) const {}
};

constexpr float RMS_EPS = 1e-6f;
DI float rs_of_row(const float* SS, int row, int fq) {
    const f32x4 a = *(const f32x4*)(SS + (size_t)row * 32 + 8 * fq), b = *(const f32x4*)(SS + (size_t)row * 32 + 8 * fq + 4);
    float s = ((a[0] + a[1]) + (a[2] + a[3])) + ((b[0] + b[1]) + (b[2] + b[3]));
    s = xsum32(xsum16(s));
    return __builtin_amdgcn_rsqf(s * (1.0f / 1024.0f) + RMS_EPS);
}
DI u32x4 pack8(const f32x4 v0, const f32x4 v1) { u32x4 w; w.x = pk2(v0[0], v0[1]); w.y = pk2(v0[2], v0[3]); w.z = pk2(v1[0], v1[1]); w.w = pk2(v1[2], v1[3]); return w; }
DI float gelu_tanh(float x) { const float u = 0.7978845608028654f * (x + 0.044715f * x * x * x); return x * frcp(1.0f + fexp(-2.0f * u)); }
DI float silu_f(float x) { return x * frcp(1.0f + fexp(-x)); }

struct XupdR8 {
    static constexpr bool NEED_RS = false, HAS_PRE = true;
    bf16_t* XB; float* SS; float scale;
    DI u32x4 pre(int row, int col) const { return *(const u32x4*)(XB + (size_t)row * 1024 + col); }
    DI void row8p(int row, int col, f32x4 v0, f32x4 v1, const u32x4 w, int fq) const {
        f32x4 x0 = (f32x4){bf_lo(w.x), bf_hi(w.x), bf_lo(w.y), bf_hi(w.y)}, x1 = (f32x4){bf_lo(w.z), bf_hi(w.z), bf_lo(w.w), bf_hi(w.w)};
        x0 = x0 + v0 * scale; x1 = x1 + v1 * scale;
        *(u32x4*)(XB + (size_t)row * 1024 + col) = pack8(x0, x1);
        float s = ((x0[0] * x0[0] + x0[1] * x0[1]) + (x0[2] * x0[2] + x0[3] * x0[3])) + ((x1[0] * x1[0] + x1[1] * x1[1]) + (x1[2] * x1[2] + x1[3] * x1[3]));
        s = xsum32(xsum16(s));
        if (fq == 0) SS[(size_t)row * 32 + (col >> 5)] = s;
    }
    DI void row8(int row, int col, f32x4 v0, f32x4 v1, float, int fq) const { row8p(row, col, v0, v1, pre(row, col), fq); }
    DI void row8i(int row, int col, f32x4 x0, f32x4 x1, int fq) const {
        *(u32x4*)(XB + (size_t)row * 1024 + col) = pack8(x0, x1);
        float s = ((x0[0] * x0[0] + x0[1] * x0[1]) + (x0[2] * x0[2] + x0[3] * x0[3])) + ((x1[0] * x1[0] + x1[1] * x1[1]) + (x1[2] * x1[2] + x1[3] * x1[3]));
        s = xsum32(xsum16(s));
        if (fq == 0) SS[(size_t)row * 32 + (col >> 5)] = s;
    }
};
template <int MODE> struct RsBf16R8 {
    static constexpr bool NEED_RS = true, HAS_PRE = false;
    bf16_t* O; int ldc; const float* SS; const PG8_LAS float* rsl;
    DI void row8(int row, int col, f32x4 v0, f32x4 v1, float r, int) const {
        v0 = v0 * r; v1 = v1 * r;
        if (MODE == 1) {
#pragma unroll
            for (int j = 0; j < 4; ++j) { const float a = v0[j] > 0.f ? v0[j] : 0.f, b = v1[j] > 0.f ? v1[j] : 0.f; v0[j] = a * a; v1[j] = b * b; } }
        *(u32x4*)(O + (size_t)row * ldc + col) = pack8(v0, v1);
    }
};
struct RgInR8 {
    static constexpr bool NEED_RS = true, HAS_PRE = false;
    bf16_t* GATE; bf16_t* XBR; const float* SS; float* convP; float* convS; const PG8_LAS float* rsl;
    DI void row8(int row, int col, f32x4 v0, f32x4 v1, float r, int) const {
        v0 = v0 * r; v1 = v1 * r;
        if (col < 1024) {
#pragma unroll
            for (int j = 0; j < 4; ++j) { v0[j] = gelu_tanh(v0[j]); v1[j] = gelu_tanh(v1[j]); }
            *(u32x4*)(GATE + (size_t)row * 1024 + col) = pack8(v0, v1);
        } else {
            const int c = col - 1024; float* tail = nullptr;
            if (row < 16384) { const int t = row & 2047; if (t >= 2045) tail = convP + ((size_t)(row >> 11) * 3 + (t - 2045)) * 1024 + c; }
            else { const int rr = row - 16384, t = rr & 7; if (t >= 5) tail = convS + ((size_t)(rr >> 3) * 3 + (t - 5)) * 1024 + c; }
            if (tail) { *(f32x4*)tail = v0; *(f32x4*)(tail + 4) = v1; }
            *(u32x4*)(XBR + (size_t)row * 1024 + c) = pack8(v0, v1);
        }
    }
};
struct GlaInR8 {
    static constexpr bool NEED_RS = true, HAS_PRE = false;
    bf16_t* QKVG; const float* SS; const PG8_LAS float* rsl;
    DI void row8(int row, int col, f32x4 v0, f32x4 v1, float r, int) const {
        v0 = v0 * r; v1 = v1 * r;
        if (col >= 2048) {
#pragma unroll
            for (int j = 0; j < 4; ++j) { v0[j] = silu_f(v0[j]); v1[j] = silu_f(v1[j]); } }
        *(u32x4*)(QKVG + (size_t)row * 3072 + col) = pack8(v0, v1);
    }
};
struct MemKVR8 {
    static constexpr bool NEED_RS = false, HAS_PRE = false;
    float* outK; float* outV; bf16_t* KPB; bf16_t* VPB; const float* SS;
    DI void row8(int row, int col, f32x4 v0, f32x4 v1, float, int) const {
        const int l = col >> 11, kv = (col >> 10) & 1, c = col & 1023;
        const size_t off = (size_t)l * 2048 * 1024 + (size_t)row * 1024 + c;
        float* of = (kv ? outV : outK) + off; __builtin_nontemporal_store(v0, (f32x4*)of); __builtin_nontemporal_store(v1, (f32x4*)(of + 4));
        *(u32x4*)((kv ? VPB : KPB) + off) = pack8(v0, v1);
    }
};
struct GroupOrder {
    int ppg, nN, grp, rank; bool rev = false; int rot = 0;
    DI bool next(int i, Unit& u) const { const int L = i * 32 + rank; if (L >= ppg * nN) return false; u.pm = ppg * grp + (L % ppg); const int p0 = L / ppg, p1 = p0 + rot; u.pn = rev ? nN - 1 - p0 : (p1 >= nN ? p1 - nN : p1); return true; }
    DI void a_ready(const Unit&) const {}
    DI void done(const Unit&) const {}
};
template <class R8, int TAG = 0> struct BigEpi {
    static constexpr bool PERM = true, AFTER_DRAIN = false, HAS_INIT = R8::HAS_PRE;
    R8 e;
    DI void init_issue(u32x4 (&w)[R8::HAS_PRE ? 16 : 1], const Unit& u, int wr, int wc, int fr, int fq) const {
        if constexpr (R8::HAS_PRE) {
            const int row0 = u.pm * BM + wr * 64 + fr, col0 = u.pn * BM + wc * 32 + 8 * fq;
#pragma unroll
            for (int ai = 0; ai < 2; ++ai)
#pragma unroll
                for (int m = 0; m < 4; ++m)
#pragma unroll
                    for (int bj = 0; bj < 2; ++bj) w[(ai * 4 + m) * 2 + bj] = e.pre(row0 + ai * HALF + m * 16, col0 + bj * HALF);
        }
    }
    DI void init_finish(f32x4 (&acc)[2][2][4][2], const u32x4 (&w)[R8::HAS_PRE ? 16 : 1]) const {
        if constexpr (R8::HAS_PRE) {
#pragma unroll
            for (int ai = 0; ai < 2; ++ai)
#pragma unroll
                for (int m = 0; m < 4; ++m)
#pragma unroll
                    for (int bj = 0; bj < 2; ++bj) { const u32x4 v = w[(ai * 4 + m) * 2 + bj];
                        acc[ai][bj][m][0] = (f32x4){bf_lo(v.x), bf_hi(v.x), bf_lo(v.y), bf_hi(v.y)}; acc[ai][bj][m][1] = (f32x4){bf_lo(v.z), bf_hi(v.z), bf_lo(v.w), bf_hi(v.w)}; }
        }
    }
    DI void init(f32x4 (&acc)[2][2][4][2], const Unit& u, int wr, int wc, int fr, int fq) const { u32x4 w[R8::HAS_PRE ? 16 : 1]; init_issue(w, u, wr, wc, fr, fq); init_finish(acc, w); }
    DI void operator()(const f32x4 (&acc)[2][2][4][2], const Unit& u, int wr, int wc, int fr, int fq) const {
        const int row0 = u.pm * BM + wr * 64 + fr, col0 = u.pn * BM + wc * 32 + 8 * fq;
        if constexpr (R8::HAS_PRE) {
#pragma unroll
            for (int ai = 0; ai < 2; ++ai)
#pragma unroll
                for (int m = 0; m < 4; ++m)
#pragma unroll
                    for (int bj = 0; bj < 2; ++bj) e.row8i(row0 + ai * HALF + m * 16, col0 + bj * HALF, acc[ai][bj][m][0], acc[ai][bj][m][1], fq);
        } else {
            float rs[2][4];
#pragma unroll
            for (int ai = 0; ai < 2; ++ai)
#pragma unroll
                for (int m = 0; m < 4; ++m) { if constexpr (R8::NEED_RS) rs[ai][m] = e.rsl[wr * 64 + fr + ai * HALF + m * 16]; else rs[ai][m] = 1.f; }
#pragma unroll
            for (int ai = 0; ai < 2; ++ai)
#pragma unroll
                for (int m = 0; m < 4; ++m) {
#pragma unroll
                    for (int bj = 0; bj < 2; ++bj) e.row8(row0 + ai * HALF + m * 16, col0 + bj * HALF, acc[ai][bj][m][0], acc[ai][bj][m][1], rs[ai][m], fq);
                }
        }
    }
};

template <class Epi, class Sched, bool ALIGN_EPI = false, bool SP2 = false>
__device__ __forceinline__ void gemm_phase(PG8_LAS unsigned char* lds, const Gemm g, const Sched& S, const Epi& E, const int tid) {
    const int wid = __builtin_amdgcn_readfirstlane(tid >> 6), lane = tid & 63, wr = wid >> 2, wc = wid & 3, fr = lane & 15, fq = lane >> 4;
    const int K = g.K, nt = K / BK;
    unsigned voffA[2], voffB[2];
#pragma unroll
    for (int i = 0; i < 2; ++i) { int R, C; stage_rc(tid * 16 + i * 8192, R, C); const int Rb = Epi::PERM ? ((R & ~31) + perm32(R & 31)) : R;
        voffA[i] = (unsigned)(R * K + C) * 2u; voffB[i] = (unsigned)(Rb * K + C) * 2u; }
    const size_t kstep = (size_t)(BK * 2);
    const size_t hstep = (size_t)HALF * K * 2;
    const size_t tstep = 2 * hstep;
    const unsigned ldsw = (unsigned)wid * 1024u;
    const int aoff = lds_byte(wr * 64 + fr, fq * 8), boff = lds_byte(wc * 32 + fr, fq * 8);
#define PG8_SA(b, h) (((b) * 2 + (h)) * HTB)
#define PG8_SB(b, h) ((4 + (b) * 2 + (h)) * HTB)
#define PG8_STAGE(bufoff, gbase, voff) do { _Pragma("unroll") for (int _i = 0; _i < 2; ++_i) \
        __builtin_amdgcn_global_load_lds((const unsigned*)((const char*)(gbase) + (voff)[_i]), (PG8_LAS unsigned*)(lds + (bufoff) + ldsw + _i * 8192), 16, 0, 0); } while (0)
#define PG8_LDA(dst, b, h) do { _Pragma("unroll") for (int m = 0; m < 4; ++m) _Pragma("unroll") for (int k = 0; k < 2; ++k) dst[m][k] = *(const PG8_LAS bf16x8*)(lds + PG8_SA(b, h) + aoff + m * 2048 + k * 1024); } while (0)
#define PG8_LDB(dst, b, h) do { _Pragma("unroll") for (int n = 0; n < 2; ++n) _Pragma("unroll") for (int k = 0; k < 2; ++k) dst[n][k] = *(const PG8_LAS bf16x8*)(lds + PG8_SB(b, h) + boff + n * 2048 + k * 1024); } while (0)
#define PG8_MMA(ai, bj, At, Bt) do { __builtin_amdgcn_s_setprio(1); _Pragma("unroll") for (int m = 0; m < 4; ++m) _Pragma("unroll") for (int n = 0; n < 2; ++n) _Pragma("unroll") for (int k = 0; k < 2; ++k) \
        acc[ai][bj][m][n] = __builtin_amdgcn_mfma_f32_16x16x32_bf16(Bt[n][k], At[m][k], acc[ai][bj][m][n], 0, 0, 0); __builtin_amdgcn_s_setprio(0); } while (0)
#define PG8_WAIT_V(n) asm volatile("s_waitcnt vmcnt(" #n ")" ::: "memory")
#define PG8_WAIT_L(n) asm volatile("s_waitcnt lgkmcnt(" #n ")" ::: "memory")
#define PG8_BAR __builtin_amdgcn_s_barrier()
#define PG8_SCHED __builtin_amdgcn_sched_barrier(0)
    Unit cur, nxt; int ui = 0;
    if (!S.next(0, cur)) return;
    f32x4 acc[2][2][4][2];
    u32x4 iw_[Epi::HAS_INIT ? 16 : 1];
    if constexpr (Epi::HAS_INIT) E.init_issue(iw_, cur, wr, wc, fr, fq);
    else {
#pragma unroll
    for (int a = 0; a < 2; ++a)
#pragma unroll
        for (int b = 0; b < 2; ++b)
#pragma unroll
            for (int m = 0; m < 4; ++m)
#pragma unroll
                for (int n = 0; n < 2; ++n) acc[a][b][m][n] = (f32x4){0.f, 0.f, 0.f, 0.f};
    }
    bf16x8 At[4][2], B0[2][2], B1[2][2];
    const char* cA = (const char*)g.A + (size_t)cur.pm * tstep; const char* cB = (const char*)g.Bt + (size_t)cur.pn * tstep;
    S.a_ready(cur);
    if constexpr (SP2) {
        PG8_STAGE(PG8_SB(0, 0), cB, voffB); PG8_STAGE(PG8_SB(0, 1), cB + hstep, voffB); PG8_STAGE(PG8_SA(0, 0), cA, voffA); PG8_STAGE(PG8_SA(0, 1), cA + hstep, voffA);
        if (wr == 1) PG8_BAR;
        PG8_WAIT_V(2); PG8_BAR;
        PG8_STAGE(PG8_SB(1, 0), cB + kstep, voffB); PG8_STAGE(PG8_SA(1, 0), cA + kstep, voffA); PG8_STAGE(PG8_SB(1, 1), cB + hstep + kstep, voffB);
        PG8_WAIT_V(6); PG8_BAR;
    } else {
        PG8_STAGE(PG8_SB(0, 0), cB, voffB); PG8_STAGE(PG8_SA(0, 0), cA, voffA); PG8_STAGE(PG8_SB(0, 1), cB + hstep, voffB); PG8_STAGE(PG8_SA(0, 1), cA + hstep, voffA);
        if (wr == 1) PG8_BAR;
        PG8_WAIT_V(4); PG8_BAR;
        PG8_STAGE(PG8_SB(1, 0), cB + kstep, voffB); PG8_STAGE(PG8_SA(1, 0), cA + kstep, voffA); PG8_STAGE(PG8_SB(1, 1), cB + hstep + kstep, voffB);
        PG8_WAIT_V(6); PG8_BAR;
    }
    if constexpr (Epi::HAS_INIT) E.init_finish(acc, iw_);
    for (;;) {
        const bool has_next = S.next(ui + 1, nxt);
        const char* nA = has_next ? (const char*)g.A + (size_t)nxt.pm * tstep : cA; const char* nB = has_next ? (const char*)g.Bt + (size_t)nxt.pn * tstep : cB;
        for (int t = 0; t < nt; t += 2) {
            const bool last = (t == nt - 2);
            const char* a1 = cA + (size_t)(t + 1) * kstep;
            const char* a2 = last ? nA : cA + (size_t)(t + 2) * kstep; const char* b2 = last ? nB : cB + (size_t)(t + 2) * kstep;
            const char* a3 = a2 + kstep; const char* b3 = b2 + kstep;
            if (last && has_next) S.a_ready(nxt);
            if constexpr (SP2) {
            PG8_LDB(B0, 0, 0); PG8_LDB(B1, 0, 1); PG8_SCHED; PG8_LDA(At, 0, 0); PG8_STAGE(PG8_SA(1, 1), a1 + hstep, voffA);
            PG8_WAIT_V(8); PG8_WAIT_L(0); PG8_BAR; PG8_MMA(0, 0, At, B0); PG8_MMA(0, 1, At, B1); PG8_BAR; PG8_SCHED;
            PG8_LDA(At, 0, 1); PG8_STAGE(PG8_SB(0, 0), b2, voffB); PG8_STAGE(PG8_SB(0, 1), b2 + hstep, voffB); PG8_STAGE(PG8_SA(0, 0), a2, voffA);
            PG8_WAIT_V(8); PG8_WAIT_L(0); PG8_BAR; PG8_MMA(1, 0, At, B0); PG8_MMA(1, 1, At, B1); PG8_BAR; PG8_SCHED;
            PG8_LDB(B0, 1, 0); PG8_LDB(B1, 1, 1); PG8_SCHED; PG8_LDA(At, 1, 0); PG8_STAGE(PG8_SA(0, 1), a2 + hstep, voffA);
            PG8_WAIT_V(8); PG8_WAIT_L(0); PG8_BAR; PG8_MMA(0, 0, At, B0); PG8_MMA(0, 1, At, B1); PG8_BAR; PG8_SCHED;
            PG8_LDA(At, 1, 1); PG8_STAGE(PG8_SB(1, 0), b3, voffB); PG8_STAGE(PG8_SB(1, 1), b3 + hstep, voffB); PG8_STAGE(PG8_SA(1, 0), a3, voffA);
            PG8_WAIT_V(8); PG8_WAIT_L(0); PG8_BAR; PG8_MMA(1, 0, At, B0); PG8_MMA(1, 1, At, B1); PG8_BAR; PG8_SCHED;
            } else {
            PG8_LDB(B0, 0, 0); PG8_SCHED; PG8_LDA(At, 0, 0); PG8_STAGE(PG8_SA(1, 1), a1 + hstep, voffA);
            PG8_WAIT_L(8); PG8_BAR; PG8_WAIT_L(0); PG8_MMA(0, 0, At, B0); PG8_BAR; PG8_SCHED;
            PG8_LDB(B1, 0, 1); PG8_STAGE(PG8_SB(0, 0), b2, voffB);
            PG8_BAR; PG8_WAIT_L(0); PG8_MMA(0, 1, At, B1); PG8_BAR;
            PG8_LDA(At, 0, 1); PG8_STAGE(PG8_SA(0, 0), a2, voffA);
            PG8_BAR; PG8_WAIT_L(0); PG8_MMA(1, 0, At, B0); PG8_BAR; PG8_SCHED;
            PG8_STAGE(PG8_SB(0, 1), b2 + hstep, voffB);
            PG8_WAIT_V(6); PG8_BAR; PG8_MMA(1, 1, At, B1); PG8_BAR;
            PG8_LDB(B0, 1, 0); PG8_SCHED; PG8_LDA(At, 1, 0); PG8_STAGE(PG8_SA(0, 1), a2 + hstep, voffA);
            PG8_WAIT_L(8); PG8_BAR; PG8_WAIT_L(0); PG8_MMA(0, 0, At, B0); PG8_BAR; PG8_SCHED;
            PG8_LDB(B1, 1, 1); PG8_STAGE(PG8_SB(1, 0), b3, voffB);
            PG8_BAR; PG8_WAIT_L(0); PG8_MMA(0, 1, At, B1); PG8_BAR;
            PG8_LDA(At, 1, 1); PG8_STAGE(PG8_SA(1, 0), a3, voffA);
            PG8_BAR; PG8_WAIT_L(0); PG8_MMA(1, 0, At, B0); PG8_BAR; PG8_SCHED;
            PG8_STAGE(PG8_SB(1, 1), b3 + hstep, voffB);
            PG8_WAIT_V(6); PG8_BAR; PG8_MMA(1, 1, At, B1); PG8_BAR;
            }
        }
        if constexpr (ALIGN_EPI) { if (wr == 0) PG8_BAR; }
        if constexpr (!Epi::AFTER_DRAIN) { E(acc, cur, wr, wc, fr, fq); S.done(cur); }
        if (!has_next) break;
        if constexpr (Epi::HAS_INIT) E.init(acc, nxt, wr, wc, fr, fq);
        else {
#pragma unroll
        for (int a = 0; a < 2; ++a)
#pragma unroll
            for (int b = 0; b < 2; ++b)
#pragma unroll
                for (int m = 0; m < 4; ++m)
#pragma unroll
                    for (int n = 0; n < 2; ++n) acc[a][b][m][n] = (f32x4){0.f, 0.f, 0.f, 0.f};
        }
        cur = nxt; cA = nA; cB = nB; ++ui;
        if constexpr (ALIGN_EPI) { if (wr == 1) PG8_BAR; }
    }
    PG8_WAIT_V(0);
    if constexpr (!ALIGN_EPI) { if (wr == 0) PG8_BAR; }
    PG8_BAR;
    if constexpr (Epi::AFTER_DRAIN) { E.fused(acc, cur, wr, wc, fr, fq, lds, wid, lane); S.done(cur); }
#undef PG8_SA
#undef PG8_SB
#undef PG8_STAGE
#undef PG8_LDA
#undef PG8_LDB
#undef PG8_MMA
#undef PG8_WAIT_V
#undef PG8_WAIT_L
#undef PG8_BAR
#undef PG8_SCHED
}
}
#define XB_TMO      128
#define XB_XCNT(j)  (256  + 64 * (j))
#define XB_XSUB(j)  (1280 + 64 * (j))
#define XB_XGEN(j)  (2304 + 64 * (j))
#define XB_TOP      3328
#define XB_TOPGEN   3392
#define XCD_BAR_WORDS 3456
#define XB_SPIN_CAP (1u << 18)

__device__ __forceinline__ unsigned xb_ld(unsigned* p)              { return __hip_atomic_load(p, __ATOMIC_RELAXED, __HIP_MEMORY_SCOPE_AGENT); }
__device__ __forceinline__ unsigned xb_add(unsigned* p, unsigned v) { return __hip_atomic_fetch_add(p, v, __ATOMIC_RELAXED, __HIP_MEMORY_SCOPE_AGENT); }
__device__ __forceinline__ unsigned xb_xcc_id() { return (unsigned)__builtin_amdgcn_s_getreg((3 << 11) | 20) & 0xFu; }
#define XB_SPIN(cond, bar) do { unsigned _sp = 0; while (cond) { __builtin_amdgcn_s_sleep(1); \
    if ((++_sp & 255u) == 0u) { if (xb_ld(&(bar)[XB_TMO])) break; if (_sp > XB_SPIN_CAP) { atomicAdd(&(bar)[XB_TMO], 1u); break; } } } } while (0)

struct XcdBarrier {
    unsigned* bar; unsigned x;
    volatile LAS unsigned* st;
};

__device__ __forceinline__ XcdBarrier xcd_barrier_post(unsigned* bar, volatile LAS unsigned* st) {
    XcdBarrier b; b.bar = bar; b.x = xb_xcc_id(); b.st = st;
    if (threadIdx.x == 0) (void)xb_add(&bar[XB_XCNT(b.x)], 1u);
    return b;
}
__device__ __forceinline__ void xcd_barrier_complete(unsigned* bar, unsigned x, unsigned& nloc, unsigned& nx) {
    const unsigned G = gridDim.x * gridDim.y * gridDim.z;
    unsigned sum, cnt, mine, sp = 0u;
    for (;;) {
        sum = 0u; cnt = 0u; mine = 0u;
#pragma unroll
        for (unsigned j = 0; j < 16; ++j) { const unsigned c = xb_ld(&bar[XB_XCNT(j)]); sum += c; cnt += (c > 0u) ? 1u : 0u; mine = (j == x) ? c : mine; }
        if (sum == G) break;
        __builtin_amdgcn_s_sleep(1);
        if ((++sp & 255u) == 0u) { if (xb_ld(&bar[XB_TMO])) break; if (sp > XB_SPIN_CAP) { atomicAdd(&bar[XB_TMO], 1u); break; } }
    }
    nloc = mine > 0u ? mine : 1u; nx = cnt > 0u ? cnt : 1u;
}

__device__ __forceinline__ void xcd_barrier(const XcdBarrier& b) {
    asm volatile("s_waitcnt vmcnt(0)" ::: "memory");
    __syncthreads();
    if (threadIdx.x == 0) {
        unsigned* bar = b.bar;
        __builtin_amdgcn_s_waitcnt(0);
        unsigned nloc = b.st[0], nx = b.st[1];
        if (nloc == 0u) { xcd_barrier_complete(bar, b.x, nloc, nx); b.st[0] = nloc; b.st[1] = nx; }
        const unsigned old = xb_add(&bar[XB_XSUB(b.x)], 1u);
        const unsigned gen = old / nloc;
        if (old + 1u == (gen + 1u) * nloc) {
            __builtin_amdgcn_fence(__ATOMIC_RELEASE, "agent");
            asm volatile("s_waitcnt vmcnt(0)" ::: "memory");
            const unsigned og = xb_add(&bar[XB_TOP], 1u);
            const unsigned tg = og / nx;
            if (og + 1u == (tg + 1u) * nx) xb_add(&bar[XB_TOPGEN], 1u);
            else XB_SPIN(xb_ld(&bar[XB_TOPGEN]) == tg, bar);
            __builtin_amdgcn_fence(__ATOMIC_ACQUIRE, "agent");
            xb_add(&bar[XB_XGEN(b.x)], 1u);
            asm volatile("s_waitcnt vmcnt(0)" ::: "memory");
        } else {
            XB_SPIN(xb_ld(&bar[XB_XGEN(b.x)]) == gen, bar);
            __builtin_amdgcn_fence(__ATOMIC_ACQUIRE, "agent");
            asm volatile("s_waitcnt vmcnt(0)" ::: "memory");
        }
    }
    __syncthreads();
}

__device__ __forceinline__ void grp_barrier_complete(unsigned* bar, unsigned x, unsigned G, unsigned& nloc, unsigned& nx) {
    unsigned sum, cnt, mine, sp = 0u;
    for (;;) {
        sum = 0u; cnt = 0u; mine = 0u;
#pragma unroll
        for (unsigned j = 0; j < 16; ++j) { const unsigned c = xb_ld(&bar[XB_XCNT(j)]); sum += c; cnt += (c > 0u) ? 1u : 0u; mine = (j == x) ? c : mine; }
        if (sum == G) break;
        __builtin_amdgcn_s_sleep(1);
        if ((++sp & 255u) == 0u) { if (xb_ld(&bar[XB_TMO])) break; if (sp > XB_SPIN_CAP) { atomicAdd(&bar[XB_TMO], 1u); break; } }
    }
    nloc = mine > 0u ? mine : 1u; nx = cnt > 0u ? cnt : 1u;
}

__device__ __forceinline__ void grp_barrier(const XcdBarrier& b, unsigned gsz) {
    asm volatile("s_waitcnt vmcnt(0)" ::: "memory");
    __syncthreads();
    if (threadIdx.x == 0) {
        unsigned* bar = b.bar;
        __builtin_amdgcn_s_waitcnt(0);
        unsigned nloc = b.st[0], nx = b.st[1];
        if (nloc == 0u) { grp_barrier_complete(bar, b.x, gsz, nloc, nx); b.st[0] = nloc; b.st[1] = nx; }
        const unsigned old = xb_add(&bar[XB_XSUB(b.x)], 1u);
        const bool early = (nx == 1u);
        if (early) __builtin_amdgcn_fence(__ATOMIC_ACQUIRE, "agent");
        const unsigned gen = old / nloc;
        if (old + 1u == (gen + 1u) * nloc) {
            if (nx > 1u) __builtin_amdgcn_fence(__ATOMIC_RELEASE, "agent");
            if (!early) asm volatile("s_waitcnt vmcnt(0)" ::: "memory");
            if (!early) {
            const unsigned og = xb_add(&bar[XB_TOP], 1u);
            const unsigned tg = og / nx;
            if (og + 1u == (tg + 1u) * nx) xb_add(&bar[XB_TOPGEN], 1u);
            else XB_SPIN(xb_ld(&bar[XB_TOPGEN]) == tg, bar);
            }
            if (!early) __builtin_amdgcn_fence(__ATOMIC_ACQUIRE, "agent");
            xb_add(&bar[XB_XGEN(b.x)], 1u);
            asm volatile("s_waitcnt vmcnt(0)" ::: "memory");
        } else {
            XB_SPIN(xb_ld(&bar[XB_XGEN(b.x)]) == gen, bar);
            if (!early) __builtin_amdgcn_fence(__ATOMIC_ACQUIRE, "agent");
            asm volatile("s_waitcnt vmcnt(0)" ::: "memory");
        }
    }
    __syncthreads();
}

constexpr int NWAVES = 8, NTHREADS = 512;
constexpr int DM = 1024, MP = 16384, MS = 1024, MTOT = 17408;
constexpr int DFF = 4096, GINP = 3328, GIN = 3088;
constexpr float EPSN = 1e-6f;
constexpr float LOG2E = 1.4426950408889634f;
enum { I_XP = 0, I_XS, I_MEM, I_RGH, I_RGCONV, I_GLAS, I_CK, I_CV, I_NMIX, I_NXA, I_NMEM, I_NMLP, I_NFIN, I_RGWIN, I_RGCW, I_RGCB, I_RGWA, I_RGBA, I_RGWX, I_RGBX, I_RGLAM, I_RGWOUT,
       I_GLAWIN, I_GLAWA2, I_GLABA, I_GLANG, I_GLAWOUT, I_WQ, I_WK, I_WV, I_WO, I_W1, I_W2, N_IN };
constexpr size_t O_YP = 0, O_YS = 16777216, O_MK = 17825792, O_MV = 26214400, O_HP = 34603008, O_CP = 34619392, O_SP = 34668544, O_HS = 36765696, O_CS = 37027840, O_SS = 37814272, O_END = 71368704;
constexpr size_t MiB = 1u << 20;
constexpr size_t WS_CTL = 0, CTL_ZERO_BYTES = 1 * MiB;
constexpr size_t WS_WQ = 1 * MiB, WS_WO = 9 * MiB, WS_WKV = 17 * MiB, WS_W1 = 33 * MiB, WS_W2 = 65 * MiB, WS_RGWIN = 97 * MiB, WS_RGWOUT = 105 * MiB, WS_GLAWIN = 109 * MiB, WS_GLAWOUT = 122 * MiB, WS_WG = 126 * MiB;
constexpr size_t WS_X = 127 * MiB, WS_XB = 195 * MiB, WS_SSQ = 738 * MiB, WS_MN = 231 * MiB, WS_KPB = 235 * MiB, WS_VPB = 251 * MiB, WS_A1 = 267 * MiB, WS_A2 = 301 * MiB, WS_A3 = 335 * MiB;
constexpr size_t WS_H1 = 369 * MiB, WS_QKVG = 505 * MiB, WS_ALO = 607 * MiB, WS_DS = 609 * MiB, WS_SC = 673 * MiB, WS_GD = 737 * MiB, WS_LA = 741 * MiB, WS_END = 776 * MiB;
constexpr int CW_BAR = 4096;
constexpr int LDS_BYTES = 147456;
constexpr int MISC_OFF = 143360;
constexpr int KV_PITCH = 528;
constexpr int K128_PITCH = 272;

struct Args { const float* in[N_IN]; float* out; unsigned char* ws; };
#define CAS __attribute__((address_space(4)))
typedef const CAS Args* ArgsP;

DI f32x16 mfma32(bf16x8 a, bf16x8 b, f32x16 c) { return __builtin_amdgcn_mfma_f32_32x32x16_bf16(a, b, c, 0, 0, 0); }
DI f32x16 zero16() { f32x16 z;
#pragma unroll
    for (int i = 0; i < 16; ++i) z[i] = 0.f; return z; }
DI int crow(int i, int hh) { return (i & 3) + 8 * (i >> 2) + 4 * hh; }
DI bf16x8 tr_frag(LAS unsigned char* img, int pitch, int k0, int k1, int n0, int lane) {
    const int i16 = lane & 15, q4 = i16 >> 2, p4 = i16 & 3, blk = (lane >> 4) & 1;
    const int cb = (n0 + 16 * blk) * 2 + 8 * p4;
    const s16x4 lo = __builtin_amdgcn_ds_read_tr16_b64_v4i16((LAS s16x4*)(img + (k0 + q4) * pitch + cb));
    const s16x4 hi = __builtin_amdgcn_ds_read_tr16_b64_v4i16((LAS s16x4*)(img + (k1 + q4) * pitch + cb));
    return __builtin_shufflevector(lo, hi, 0, 1, 2, 3, 4, 5, 6, 7);
}
DI bf16x8 pack_step(const f32x16& x, int s, float scale) {
    u32x4 p;
    p.x = pk2(x[8 * s + 0] * scale, x[8 * s + 1] * scale); p.y = pk2(x[8 * s + 2] * scale, x[8 * s + 3] * scale);
    p.z = pk2(x[8 * s + 4] * scale, x[8 * s + 5] * scale); p.w = pk2(x[8 * s + 6] * scale, x[8 * s + 7] * scale);
    return __builtin_bit_cast(bf16x8, p);
}

DI void p0_item(const float* W, int ldw, int ncol_valid, int K, const float* rscale, int kmask, float cs, bf16* WT, LAS unsigned* scr, int kb, int nb, int lane) {
    const int k0 = 64 * kb, n0 = 64 * nb, n4 = lane & 15, kr = lane >> 4; const bool ok = n0 + 4 * n4 < ncol_valid;
    const float* src = W + (size_t)(k0 + 2 * kr) * ldw + n0 + 4 * n4;
    f32x4 va[8], vb[8];
#pragma unroll
    for (int i = 0; i < 8; ++i) { va[i] = (f32x4){0.f, 0.f, 0.f, 0.f}; vb[i] = va[i]; if (ok) { va[i] = __builtin_nontemporal_load((const f32x4*)(src + (size_t)(8 * i) * ldw)); vb[i] = __builtin_nontemporal_load((const f32x4*)(src + (size_t)(8 * i + 1) * ldw)); } }
#pragma unroll
    for (int i = 0; i < 8; ++i) { const int k = k0 + 2 * kr + 8 * i; float sa = cs, sb = cs; if (rscale) { sa *= rscale[k & kmask]; sb *= rscale[(k + 1) & kmask]; }
#pragma unroll
        for (int j = 0; j < 4; ++j) scr[(4 * n4 + j) * 33 + kr + 4 * i] = pk2(va[i][j] * sa, vb[i][j] * sb); }
    LDS_WAIT(); asm volatile("" ::: "memory");
    const int c = lane & 7;
#pragma unroll
    for (int jj = 0; jj < 8; ++jj) { const int n = (lane >> 3) + 8 * jj; const LAS unsigned* sp = scr + n * 33 + 4 * c;
        u32x4 o; o.x = sp[0]; o.y = sp[1]; o.z = sp[2]; o.w = sp[3];
        *(u32x4*)(WT + (size_t)(n0 + n) * K + k0 + 8 * c) = o; }
    LDS_WAIT(); asm volatile("" ::: "memory");
}
DI void p0_prologue(ArgsP A, LAS unsigned char* lds, int gw, int NGW, int wave, int lane0) {
    unsigned char* ws = A->ws;
    LAS unsigned* scr = (LAS unsigned*)(lds + wave * 16384);
    constexpr int PER_L = 3072, PER_J = 1888, N_L = 4 * PER_L, NITEMS = N_L + 2 * PER_J;
#pragma unroll 1
    for (int it = gw; it < NITEMS; it += NGW) {
        int lane = lane0; asm volatile("" : "+v"(lane));
        const float* W; int ldw, ncv, K, kmask = 0, kb, nb; const float* rsc = nullptr; float cs = 1.f; bf16* WT;
        if (it < N_L) {
            const int l = it / PER_L; int r = it % PER_L; ldw = DM; ncv = DM; K = DM;
            if (r < 256) { W = A->in[I_WQ] + (size_t)l * DM * DM; rsc = A->in[I_NXA] + l * DM; kmask = 1023; cs = 0.0625f; WT = (bf16*)(ws + WS_WQ) + (size_t)l * DM * DM; kb = r / 16; nb = r % 16; }
            else if ((r -= 256) < 256) { W = A->in[I_WO] + (size_t)l * DM * DM; WT = (bf16*)(ws + WS_WO) + (size_t)l * DM * DM; kb = r / 16; nb = r % 16; }
            else if ((r -= 256) < 256) { W = A->in[I_WK] + (size_t)l * DM * DM; rsc = A->in[I_NMEM] + l * DM; kmask = 1023; WT = (bf16*)(ws + WS_WKV) + (size_t)(l * 2048) * DM; kb = r / 16; nb = r % 16; }
            else if ((r -= 256) < 256) { W = A->in[I_WV] + (size_t)l * DM * DM; rsc = A->in[I_NMEM] + l * DM; kmask = 1023; WT = (bf16*)(ws + WS_WKV) + (size_t)(l * 2048 + 1024) * DM; kb = r / 16; nb = r % 16; }
            else if ((r -= 256) < 1024) { W = A->in[I_W1] + (size_t)l * DM * DFF; ldw = DFF; ncv = DFF; rsc = A->in[I_NMLP] + l * DM; kmask = 1023; WT = (bf16*)(ws + WS_W1) + (size_t)l * DFF * DM; kb = r / 64; nb = r % 64; }
            else { r -= 1024; W = A->in[I_W2] + (size_t)l * DFF * DM; K = DFF; WT = (bf16*)(ws + WS_W2) + (size_t)l * DM * DFF; kb = r / 16; nb = r % 16; }
        } else {
            const int r2 = it - N_L; const int j = r2 / PER_J; int r = r2 % PER_J; ldw = DM; ncv = DM; K = DM;
            if (r < 512) { W = A->in[I_RGWIN] + (size_t)j * DM * 2048; ldw = 2048; ncv = 2048; rsc = A->in[I_NMIX] + (2 * j) * DM; kmask = 1023; WT = (bf16*)(ws + WS_RGWIN) + (size_t)j * 2048 * DM; kb = r / 32; nb = r % 32; }
            else if ((r -= 512) < 256) { W = A->in[I_RGWOUT] + (size_t)j * DM * DM; WT = (bf16*)(ws + WS_RGWOUT) + (size_t)j * DM * DM; kb = r / 16; nb = r % 16; }
            else if ((r -= 256) < 832) { W = A->in[I_GLAWIN] + (size_t)j * DM * GIN; ldw = GIN; ncv = GIN; rsc = A->in[I_NMIX] + (2 * j + 1) * DM; kmask = 1023; kb = r / 52; nb = r % 52; cs = nb < 8 ? 0.08838834764831845f : 1.f; WT = (bf16*)(ws + WS_GLAWIN) + (size_t)j * GINP * DM; }
            else if ((r -= 832) < 256) { W = A->in[I_GLAWOUT] + (size_t)j * DM * DM; rsc = A->in[I_GLANG] + j * 256; kmask = 255; WT = (bf16*)(ws + WS_GLAWOUT) + (size_t)j * DM * DM; kb = r / 16; nb = r % 16; }
            else if ((r -= 256) < 16) { W = A->in[I_RGWA] + (size_t)j * 16 * 64 * 64; ldw = 64; ncv = 64; WT = (bf16*)(ws + WS_WG) + (size_t)(j * 2 + 0) * 64 * DM; kb = r; nb = 0; }
            else { r -= 16; W = A->in[I_RGWX] + (size_t)j * 16 * 64 * 64; ldw = 64; ncv = 64; WT = (bf16*)(ws + WS_WG) + (size_t)(j * 2 + 1) * 64 * DM; kb = r; nb = 0; }
        }
        p0_item(W, ldw, ncv, K, rsc, kmask, cs, WT, scr, kb, nb, lane);
    }
    const int lane = lane0;
    bf16* XB = (bf16*)(ws + WS_XB); float* SS = (float*)(ws + WS_SSQ);
    for (int m = gw; m < MTOT; m += NGW) {
        const float* src = m < MP ? A->in[I_XP] + (size_t)m * DM : A->in[I_XS] + (size_t)(m - MP) * DM;
        f32x4 v[4]; float s = 0.f;
#pragma unroll
        for (int jq = 0; jq < 4; ++jq) { v[jq] = __builtin_nontemporal_load((const f32x4*)src + 64 * jq + lane); s += (v[jq][0] * v[jq][0] + v[jq][1] * v[jq][1]) + (v[jq][2] * v[jq][2] + v[jq][3] * v[jq][3]); }
        s = wave_sum(s);
#pragma unroll
        for (int jq = 0; jq < 4; ++jq) { u32x2 w; w.x = pk2(v[jq][0], v[jq][1]); w.y = pk2(v[jq][2], v[jq][3]); ((u32x2*)(XB + (size_t)m * DM))[64 * jq + lane] = w; }
        if (lane < 32) SS[(size_t)m * 32 + lane] = lane == 0 ? s : 0.f;
    }
    bf16* MN = (bf16*)(ws + WS_MN);
    for (int m = gw; m < 2048; m += NGW) {
        const float* src = A->in[I_MEM] + (size_t)m * DM;
        f32x4 v[4]; float s = 0.f;
#pragma unroll
        for (int jq = 0; jq < 4; ++jq) { v[jq] = __builtin_nontemporal_load((const f32x4*)src + 64 * jq + lane); s += (v[jq][0] * v[jq][0] + v[jq][1] * v[jq][1]) + (v[jq][2] * v[jq][2] + v[jq][3] * v[jq][3]); }
        s = wave_sum(s); const float rstd = __builtin_amdgcn_rsqf(s * (1.f / 1024.f) + EPSN);
#pragma unroll
        for (int jq = 0; jq < 4; ++jq) { u32x2 w; w.x = pk2(v[jq][0] * rstd, v[jq][1] * rstd); w.y = pk2(v[jq][2] * rstd, v[jq][3] * rstd); ((u32x2*)(MN + (size_t)m * DM))[64 * jq + lane] = w; }
    }
}

template <int RA, int NP, int NS, int KT, class R8>
DI void small_gemm(LAS unsigned char* lds, const bf16* __restrict__ A, const bf16* __restrict__ Bt, int K, int row_base, int col_base, const R8& e, int tid, int wave, int lane) {
    constexpr int WR = 4 / RA, WC = 8 / WR, C = WC * NP / 2, SUB = (1 + C) * 8192, STAGE = KT * SUB, L = KT * (1 + C);
    static_assert(NS * STAGE <= 131072 && (NS - 2) * L <= 63, "ring");
    const int wr = wave / WC, wc = wave % WC, fr = lane & 15, fq = lane >> 4;
    int R, Cc; pg8::stage_rc(tid * 16, R, Cc);
    const int Rb = (R & ~31) + pg8::perm32(R & 31);
    const bf16* asrc = A + (size_t)(row_base + R) * K + Cc;
    const bf16* bsrc = Bt + (size_t)(col_base + Rb) * K + Cc;
    const size_t bgrp = (size_t)64 * K;
    const int NT = K / (64 * KT);
#define SG_STAGE(st_, slot_) do { const int stw_ = (st_) & (NT - 1); LAS unsigned char* sb_ = lds + (slot_) * STAGE + wave * 1024; \
        _Pragma("unroll") for (int t_ = 0; t_ < KT; ++t_) { const int ko_ = 64 * (KT * stw_ + t_); \
            __builtin_amdgcn_global_load_lds((const unsigned*)(asrc + ko_), (LAS unsigned*)(sb_ + t_ * SUB), 16, 0, 0); \
            _Pragma("unroll") for (int g_ = 0; g_ < C; ++g_) __builtin_amdgcn_global_load_lds((const unsigned*)(bsrc + g_ * bgrp + ko_), (LAS unsigned*)(sb_ + t_ * SUB + 8192 * (1 + g_)), 16, 0, 0); } } while (0)
    const int r0 = row_base + 16 * (wr * RA), c0 = col_base + wc * (32 * NP);
    float rsv[RA]; u32x4 prew[RA][NP];
#pragma unroll
    for (int ra = 0; ra < RA; ++ra) { rsv[ra] = 1.f; if constexpr (R8::NEED_RS) rsv[ra] = pg8::rs_of_row(e.SS, r0 + 16 * ra + fr, fq);
#pragma unroll
        for (int np = 0; np < NP; ++np) { prew[ra][np] = (u32x4){0u, 0u, 0u, 0u}; if constexpr (R8::HAS_PRE) prew[ra][np] = e.pre(r0 + 16 * ra + fr, c0 + 32 * np + 8 * fq); } }
    f32x4 acc[RA][NP][2];
#pragma unroll
    for (int ra = 0; ra < RA; ++ra)
#pragma unroll
        for (int np = 0; np < NP; ++np) { acc[ra][np][0] = (f32x4){0.f, 0.f, 0.f, 0.f}; acc[ra][np][1] = (f32x4){0.f, 0.f, 0.f, 0.f}; }
    int aoff[RA], boff[NP][2];
#pragma unroll
    for (int ra = 0; ra < RA; ++ra) aoff[ra] = pg8::lds_byte(16 * (wr * RA + ra) + fr, 8 * fq);
#pragma unroll
    for (int np = 0; np < NP; ++np)
#pragma unroll
        for (int n = 0; n < 2; ++n) { const int rb = wc * (32 * NP) + 32 * np + 16 * n + fr; boff[np][n] = 8192 * (1 + (rb >> 6)) + pg8::lds_byte(rb & 63, 8 * fq); }
#pragma unroll
    for (int s = 0; s < NS - 1; ++s) SG_STAGE(s, s);
#pragma unroll 1
    for (int st = 0; st < NT; ++st) {
        asm volatile("s_waitcnt vmcnt(%0)" :: "n"((NS - 2) * L) : "memory");
        __builtin_amdgcn_s_barrier();
        asm volatile("" ::: "memory");
        { const int nslot = (st + NS - 1) % NS; SG_STAGE(st + NS - 1, nslot); }
        const LAS unsigned char* sb0 = lds + (st % NS) * STAGE;
#pragma unroll
        for (int t = 0; t < KT; ++t) {
            const LAS unsigned char* sb = sb0 + t * SUB;
            bf16x8 af[RA][2], bfr[NP][2][2];
#pragma unroll
            for (int ra = 0; ra < RA; ++ra) { af[ra][0] = *(const LAS bf16x8*)(sb + aoff[ra]); af[ra][1] = *(const LAS bf16x8*)(sb + aoff[ra] + 1024); }
#pragma unroll
            for (int np = 0; np < NP; ++np)
#pragma unroll
                for (int n = 0; n < 2; ++n) { bfr[np][n][0] = *(const LAS bf16x8*)(sb + boff[np][n]); bfr[np][n][1] = *(const LAS bf16x8*)(sb + boff[np][n] + 1024); }
#pragma unroll
            for (int ks = 0; ks < 2; ++ks)
#pragma unroll
                for (int ra = 0; ra < RA; ++ra)
#pragma unroll
                    for (int np = 0; np < NP; ++np) { acc[ra][np][0] = __builtin_amdgcn_mfma_f32_16x16x32_bf16(bfr[np][0][ks], af[ra][ks], acc[ra][np][0], 0, 0, 0); acc[ra][np][1] = __builtin_amdgcn_mfma_f32_16x16x32_bf16(bfr[np][1][ks], af[ra][ks], acc[ra][np][1], 0, 0, 0); }
        }
    }
#undef SG_STAGE
    asm volatile("s_waitcnt vmcnt(0)" ::: "memory");
    __builtin_amdgcn_s_barrier();
    asm volatile("" ::: "memory");
#pragma unroll
    for (int ra = 0; ra < RA; ++ra) {
        const int row = r0 + 16 * ra + fr;
#pragma unroll
        for (int np = 0; np < NP; ++np) {
            if constexpr (R8::HAS_PRE) e.row8p(row, c0 + 32 * np + 8 * fq, acc[ra][np][0], acc[ra][np][1], prew[ra][np], fq);
            else e.row8(row, c0 + 32 * np + 8 * fq, acc[ra][np][0], acc[ra][np][1], rsv[ra], fq);
        }
    }
}
DI float log_sigmoid_f(float x) { return fminf(x, 0.f) - 0.6931471805599453f * __builtin_amdgcn_logf(1.0f + fexp(-__builtin_fabsf(x))); }
DI void la_unit(const bf16* __restrict__ XB, const bf16* __restrict__ W16, const float* SS, const float* __restrict__ wa2, const float* __restrict__ ba, float* __restrict__ LA, LAS float* scr, int row0, int lane) {
    const int fr = lane & 15, fq = lane >> 4;
    const bf16* ap = XB + (size_t)(row0 + fr) * DM + 8 * fq; const bf16* bp = W16 + (size_t)fr * DM + 8 * fq;
    f32x4 acc = (f32x4){0.f, 0.f, 0.f, 0.f};
#pragma unroll 8
    for (int k0 = 0; k0 < DM; k0 += 32) acc = __builtin_amdgcn_mfma_f32_16x16x32_bf16(*(const bf16x8*)(bp + k0), *(const bf16x8*)(ap + k0), acc, 0, 0, 0);
    const float rs = pg8::rs_of_row(SS, row0 + fr, fq);
    *(LAS f32x4*)(scr + fr * 16 + 4 * fq) = acc * rs;
    LDS_WAIT(); asm volatile("" ::: "memory");
#pragma unroll 1
    for (int nb = 0; nb < 8; ++nb) {
        float w[16];
#pragma unroll
        for (int rk = 0; rk < 16; ++rk) w[rk] = wa2[rk * 512 + 64 * nb + lane];
        const float bb = ba[64 * nb + lane];
#pragma unroll 4
        for (int row = 0; row < 16; ++row) {
            const f32x4 a0 = *(const LAS f32x4*)(scr + row * 16), a1 = *(const LAS f32x4*)(scr + row * 16 + 4), a2 = *(const LAS f32x4*)(scr + row * 16 + 8), a3 = *(const LAS f32x4*)(scr + row * 16 + 12);
            float pre = bb;
#pragma unroll
            for (int q = 0; q < 4; ++q) pre += a0[q] * w[q] + a1[q] * w[4 + q] + a2[q] * w[8 + q] + a3[q] * w[12 + q];
            LA[(size_t)(row0 + row) * 512 + 64 * nb + lane] = log_sigmoid_f(pre) * 0.0625f;
        }
    }
    LDS_WAIT(); asm volatile("" ::: "memory");
}

DI void attn_stage_kv(LAS unsigned char* lds, const bf16* KVP, int b, int h, int tid) {
    const bf16* kbase = KVP + (size_t)(b * 256) * DM + h * 256;
    u32x4 v[16];
#pragma unroll
    for (int i = 0; i < 16; ++i) { const int id = tid + 512 * i, m = id >> 5, ch = id & 31; v[i] = *(const u32x4*)(kbase + (size_t)m * DM + ch * 8); }
#pragma unroll
    for (int i = 0; i < 16; ++i) { const int id = tid + 512 * i, m = id >> 5, ch = id & 31; *(LAS u32x4*)(lds + m * KV_PITCH + ch * 16) = v[i]; }
}
DI void attn_prompt_unit(LAS unsigned char* lds, const bf16* Q, const bf16* KP, const bf16* VP, bf16* AO, int b, int h, int qt, int tid, int wave, int lane, bool k_staged) {
    const int r = lane & 31, hh = lane >> 5;
    const int q0 = b * 2048 + qt * 256 + wave * 32;
    const bf16* qrow = Q + (size_t)(q0 + r) * DM + h * 256 + 8 * hh;
    bf16x8 bq[3][2];
#pragma unroll
    for (int c = 0; c < 2; ++c) { bq[0][c] = *(const bf16x8*)(qrow + 16 * c); bq[1][c] = *(const bf16x8*)(qrow + 16 * (2 + c)); }
    if (!k_staged) attn_stage_kv(lds, KP, b, h, tid);
    __syncthreads();
    f32x16 acc[8];
#pragma unroll
    for (int mt = 0; mt < 8; ++mt) acc[mt] = zero16();
#pragma unroll
    for (int g = 0; g < 8; ++g) {
        if (g < 6) {
#pragma unroll
            for (int c = 0; c < 2; ++c) bq[(g + 2) % 3][c] = *(const bf16x8*)(qrow + 16 * (2 * (g + 2) + c)); }
#pragma unroll
        for (int c = 0; c < 2; ++c) { const int kk = 2 * g + c;
#pragma unroll
            for (int mt = 0; mt < 8; ++mt) { const bf16x8 a = *(const LAS bf16x8*)(lds + (32 * mt + r) * KV_PITCH + (16 * kk + 8 * hh) * 2); acc[mt] = mfma32(a, bq[g % 3][c], acc[mt]); }
            __builtin_amdgcn_sched_barrier(0);
        }
    }
    float mx = -3.0e38f;
#pragma unroll
    for (int mt = 0; mt < 8; ++mt)
#pragma unroll
        for (int i = 0; i < 16; ++i) mx = fmaxf(mx, acc[mt][i]);
    mx = xmax32(mx);
    float sum = 0.f;
#pragma unroll
    for (int mt = 0; mt < 8; ++mt)
#pragma unroll
        for (int i = 0; i < 16; ++i) { const float p = __builtin_amdgcn_exp2f((acc[mt][i] - mx) * LOG2E); acc[mt][i] = p; sum += p; }
    sum = xsum32(sum);
    const float inv = frcp(sum);
    bf16x8 pf[8][2];
#pragma unroll
    for (int mt = 0; mt < 8; ++mt) { pf[mt][0] = pack_step(acc[mt], 0, inv); pf[mt][1] = pack_step(acc[mt], 1, inv); }
    __syncthreads();
    attn_stage_kv(lds, VP, b, h, tid);
    __syncthreads();
#pragma unroll
    for (int half = 0; half < 2; ++half) {
        f32x16 z[4];
#pragma unroll
        for (int d = 0; d < 4; ++d) z[d] = zero16();
#pragma unroll
        for (int mt = 0; mt < 8; ++mt)
#pragma unroll
            for (int ss = 0; ss < 2; ++ss) { const int k0 = 32 * mt + 16 * ss + 4 * hh;
#pragma unroll
                for (int d = 0; d < 4; ++d) { const bf16x8 bv = tr_frag(lds, KV_PITCH, k0, k0 + 8, 32 * (4 * half + d), lane); z[d] = mfma32(pf[mt][ss], bv, z[d]); } }
#pragma unroll
        for (int d = 0; d < 4; ++d)
#pragma unroll
            for (int i = 0; i < 16; ++i) AO[(size_t)(q0 + crow(i, hh)) * DM + h * 256 + 32 * (4 * half + d) + r] = f2bf(z[d][i]);
    }
}
DI void attn_sample_unit(LAS unsigned char* lds, const bf16* Q, const float* CK, const float* CV, bf16* AO, int su, int tid, int wave, int lane) {
    const int pair = wave >> 2, mq = wave & 3, bh = su * 2 + pair, b = bh >> 2, h = bh & 3;
    LAS unsigned char* wl = lds + wave * 16896;
    const int r = lane & 31, hh = lane >> 5;
    bf16x8 bq[16];
    {   const bf16* qrow = Q + (size_t)(MP + b * 8 + (r & 7)) * DM + h * 256 + 8 * hh;
#pragma unroll
        for (int kk = 0; kk < 16; ++kk) { bf16x8 v = *(const bf16x8*)(qrow + 16 * kk); if (r >= 8) { v = (bf16x8){0, 0, 0, 0, 0, 0, 0, 0}; } bq[kk] = v; } }
    const float* kb = CK + ((size_t)(b * 256 + 64 * mq) * 4 + h) * 256 + 4 * lane;
    f32x16 acc[2];
    const float* vb = CV + ((size_t)(b * 256 + 64 * mq) * 4 + h) * 256 + 4 * lane;
    f32x4 v[16];
#pragma unroll
    for (int i = 0; i < 16; ++i) v[i] = __builtin_nontemporal_load((const f32x4*)(kb + (size_t)i * 1024));
#pragma unroll
    for (int c = 0; c < 2; ++c) {
#pragma unroll
        for (int hf = 0; hf < 2; ++hf) {
#pragma unroll
            for (int i = 0; i < 16; ++i) { u32x2 w; w.x = pk2(v[i][0], v[i][1]); w.y = pk2(v[i][2], v[i][3]); *(LAS u32x2*)(wl + (16 * hf + i) * KV_PITCH + lane * 8) = w; }
            const int nb = 2 * c + hf + 1;
#pragma unroll
            for (int i = 0; i < 16; ++i) v[i] = __builtin_nontemporal_load(nb < 4 ? (const f32x4*)(kb + (size_t)(16 * nb + i) * 1024) : (const f32x4*)(vb + (size_t)i * 1024));
        }
        f32x16 a_ = zero16();
#pragma unroll
        for (int kk = 0; kk < 16; ++kk) { const bf16x8 a = *(const LAS bf16x8*)(wl + r * KV_PITCH + (16 * kk + 8 * hh) * 2); a_ = mfma32(a, bq[kk], a_); }
        acc[c] = a_;
    }
    float mx = -3.0e38f;
#pragma unroll
    for (int c = 0; c < 2; ++c)
#pragma unroll
        for (int i = 0; i < 16; ++i) mx = fmaxf(mx, acc[c][i]);
    mx = xmax32(mx);
    float sum = 0.f;
#pragma unroll
    for (int c = 0; c < 2; ++c)
#pragma unroll
        for (int i = 0; i < 16; ++i) { const float p = __builtin_amdgcn_exp2f((acc[c][i] - mx) * LOG2E); acc[c][i] = p; sum += p; }
    sum = xsum32(sum);
    LAS float* Pbuf = (LAS float*)wl;
    if (r < 8) {
#pragma unroll
        for (int c = 0; c < 2; ++c)
#pragma unroll
            for (int i = 0; i < 16; ++i) Pbuf[(32 * c + crow(i, hh)) * 8 + r] = acc[c][i];
    }
    LDS_WAIT(); asm volatile("" ::: "memory");
    f32x4 o[8];
#pragma unroll
    for (int q = 0; q < 8; ++q) o[q] = (f32x4){0.f, 0.f, 0.f, 0.f};
#pragma unroll
    for (int mb = 0; mb < 4; ++mb) {
        f32x4 v2[16];
        if (mb < 3) {
#pragma unroll
            for (int i = 0; i < 16; ++i) v2[i] = __builtin_nontemporal_load((const f32x4*)(vb + (size_t)(16 * (mb + 1) + i) * 1024)); }
#pragma unroll
        for (int i = 0; i < 16; ++i) { const f32x4 p0 = *(const LAS f32x4*)(Pbuf + (16 * mb + i) * 8), p1 = *(const LAS f32x4*)(Pbuf + (16 * mb + i) * 8 + 4);
            o[0] += v[i] * p0[0]; o[1] += v[i] * p0[1]; o[2] += v[i] * p0[2]; o[3] += v[i] * p0[3]; o[4] += v[i] * p1[0]; o[5] += v[i] * p1[1]; o[6] += v[i] * p1[2]; o[7] += v[i] * p1[3]; }
        if (mb < 3) {
#pragma unroll
            for (int i = 0; i < 16; ++i) v[i] = v2[i]; }
    }
    LAS float* Op = (LAS float*)(wl + 2048);
    LAS float* St = (LAS float*)(wl + 2048 + 8192);
#pragma unroll
    for (int q = 0; q < 8; ++q) *(LAS f32x4*)(Op + q * 256 + 4 * lane) = o[q];
    if (lane < 8) { St[lane * 2] = mx; St[lane * 2 + 1] = sum; }
    __syncthreads();
    {   const int d = 64 * mq + lane;
#pragma unroll
        for (int q = 0; q < 8; ++q) {
            float m4[4], l4[4], o4[4]; float M = -3.0e38f;
#pragma unroll
            for (int w = 0; w < 4; ++w) { LAS unsigned char* ow = lds + (pair * 4 + w) * 16896; m4[w] = ((LAS float*)(ow + 2048 + 8192))[q * 2]; l4[w] = ((LAS float*)(ow + 2048 + 8192))[q * 2 + 1]; o4[w] = ((LAS float*)(ow + 2048))[q * 256 + d]; M = fmaxf(M, m4[w]); }
            float num = 0.f, den = 0.f;
#pragma unroll
            for (int w = 0; w < 4; ++w) { const float e = __builtin_amdgcn_exp2f((m4[w] - M) * LOG2E); num += e * o4[w]; den += e * l4[w]; }
            AO[(size_t)(MP + b * 8 + q) * DM + h * 256 + d] = f2bf(num / den);
        }
    }
}

constexpr int XS_PITCH = 144;
struct RgTile { float hl[16], ac[16]; float A0[4], B0[4], A1[4], B1[4]; };
template <bool SAMPLE>
DI void rg_tile(LAS unsigned char* xs, const LAS float* cw, const bf16x8 (&Ba)[4], const bf16x8 (&Bx)[4], float ba, float bx, float spn, const float (&cwo)[5], int nt, int lane, RgTile& T) {
    const int r = lane & 31, hh = lane >> 5;
    const int rA = SAMPLE ? 11 * (r >> 3) + (r & 7) : r;
    f32x16 R = zero16(), I = zero16();
#pragma unroll
    for (int kk = 0; kk < 4; ++kk) {
        const int c8 = 16 * kk + 8 * hh;
        float a[8];
        { const f32x4 b0 = *(const LAS f32x4*)(cw + 256 + c8), b1 = *(const LAS f32x4*)(cw + 256 + c8 + 4); a[0] = b0[0]; a[1] = b0[1]; a[2] = b0[2]; a[3] = b0[3]; a[4] = b1[0]; a[5] = b1[1]; a[6] = b1[2]; a[7] = b1[3]; }
#pragma unroll
        for (int j = 0; j < 4; ++j) {
            const u32x4 xv = *(const LAS u32x4*)(xs + (rA + j) * XS_PITCH + c8 * 2);
            const f32x4 w0 = *(const LAS f32x4*)(cw + j * 64 + c8), w1 = *(const LAS f32x4*)(cw + j * 64 + c8 + 4);
            a[0] += w0[0] * bf_lo(xv.x); a[1] += w0[1] * bf_hi(xv.x); a[2] += w0[2] * bf_lo(xv.y); a[3] += w0[3] * bf_hi(xv.y);
            a[4] += w1[0] * bf_lo(xv.z); a[5] += w1[1] * bf_hi(xv.z); a[6] += w1[2] * bf_lo(xv.w); a[7] += w1[3] * bf_hi(xv.w);
        }
        u32x4 p; p.x = pk2(a[0], a[1]); p.y = pk2(a[2], a[3]); p.z = pk2(a[4], a[5]); p.w = pk2(a[6], a[7]);
        const bf16x8 af = __builtin_bit_cast(bf16x8, p);
        R = mfma32(af, Ba[kk], R); I = mfma32(af, Bx[kk], I);
    }
    const LAS unsigned char* xc0 = xs + (32 * nt + r) * 2;
#pragma unroll
    for (int g = 0; g < 4; ++g) {
        const int rb = SAMPLE ? 11 * g + 4 * hh : 8 * g + 4 * hh;
        float xw[7];
#pragma unroll
        for (int j = 0; j < 7; ++j) xw[j] = bf2f(*(const LAS bf16*)(xc0 + (rb + j) * XS_PITCH));
        float hprev = 0.f, aprev = 1.f;
#pragma unroll
        for (int k = 0; k < 4; ++k) {
            const int i = 4 * g + k;
            const float xc = cwo[4] + cwo[0] * xw[k] + cwo[1] * xw[k + 1] + cwo[2] * xw[k + 2] + cwo[3] * xw[k + 3];
            const float rr = fsigmoid(R[i] + ba), ii = fsigmoid(I[i] + bx);
            const float la = spn * rr;
            const float a = fexp(la);
            const float mult = __builtin_amdgcn_sqrtf(fmaxf(1.0f - a * a, 0.f));
            const float bt = mult * ii * xc;
            hprev = a * hprev + bt; aprev = aprev * a;
            T.hl[i] = hprev; T.ac[i] = aprev;
        }
        halves32(aprev, T.A0[g], T.A1[g]); halves32(hprev, T.B0[g], T.B1[g]);
    }
}
DI void rg_unit_setup(ArgsP A, int j, int cb, int nt, int lane, LAS float* cw, bf16x8 (&Ba)[4], bf16x8 (&Bx)[4], float& ba, float& bx, float& spn, float (&cwo)[5]) {
    const int r = lane & 31, hh = lane >> 5, cho = cb * 64 + 32 * nt + r;
    const bf16* WG = (const bf16*)(A->ws + WS_WG) + (size_t)(j * 2) * 64 * DM;
#pragma unroll
    for (int kk = 0; kk < 4; ++kk) { Ba[kk] = *(const bf16x8*)(WG + (size_t)(32 * nt + r) * DM + cb * 64 + 16 * kk + 8 * hh); Bx[kk] = *(const bf16x8*)(WG + (size_t)64 * DM + (size_t)(32 * nt + r) * DM + cb * 64 + 16 * kk + 8 * hh); }
    ba = A->in[I_RGBA][j * DM + cho]; bx = A->in[I_RGBX][j * DM + cho];
    const float lam = A->in[I_RGLAM][j * DM + cho];
    spn = -8.0f * log1pf(expf(-lam));
#pragma unroll
    for (int q = 0; q < 4; ++q) { cwo[q] = A->in[I_RGCW][(size_t)(j * 4 + q) * DM + cho]; cw[q * 64 + lane] = A->in[I_RGCW][(size_t)(j * 4 + q) * DM + cb * 64 + lane]; }
    cwo[4] = A->in[I_RGCB][j * DM + cho]; cw[256 + lane] = A->in[I_RGCB][j * DM + cb * 64 + lane];
}
struct RgPre { u32x4 xv[5], gv[2]; };
DI void rg_prefetch(const bf16* XBR, const bf16* GATE, int b, int chA, int cho0, int t0, int lane, RgPre& P) {
#pragma unroll
    for (int i = 0; i < 5; ++i) { const int id = lane + 64 * i, row = id >> 3, c16 = id & 7, t = t0 - 3 + row; u32x4 v = (u32x4){0u, 0u, 0u, 0u};
        if (id < 280 && t >= 0) v = *(const u32x4*)(XBR + (size_t)(b * 2048 + t) * DM + chA + c16 * 8); P.xv[i] = v; }
#pragma unroll
    for (int i = 0; i < 2; ++i) { const int id = lane + 64 * i, row = id >> 2, c4 = id & 3; P.gv[i] = *(const u32x4*)(GATE + (size_t)(b * 2048 + t0 + row) * DM + cho0 + 8 * c4); }
}
DI void rg_prompt_unit(ArgsP A, LAS unsigned char* lds, int j, int b, int cb, int nt, int wave, int lane) {
    const int r = lane & 31, hh = lane >> 5, cho0 = cb * 64 + 32 * nt, cho = cho0 + r, chA = cb * 64;
    LAS unsigned char* xs = lds + wave * 6400;
    LAS float* cw = (LAS float*)(lds + 51200 + wave * 1280);
    LAS float* TM = (LAS float*)(lds + 61440);
    LAS unsigned char* gs = lds + 65536 + wave * 5120;
    LAS unsigned char* os = gs + 2560;
    const bf16* XBR = (const bf16*)(A->ws + WS_A2); const bf16* GATE = (const bf16*)(A->ws + WS_A1); bf16* HG = (bf16*)(A->ws + WS_A3);
    bf16x8 Ba[4], Bx[4]; float ba, bx, spn, cwo[5];
    rg_unit_setup(A, j, cb, nt, lane, cw, Ba, Bx, ba, bx, spn, cwo);
    RgPre P; rg_prefetch(XBR, GATE, b, chA, cho0, 32 * wave, lane, P);
    float carry = 0.f;
#pragma unroll 1
    for (int ss = 0; ss < 8; ++ss) {
        const int t0 = 256 * ss + 32 * wave;
#pragma unroll
        for (int i = 0; i < 5; ++i) { const int id = lane + 64 * i; if (id < 280) *(LAS u32x4*)(xs + (id >> 3) * XS_PITCH + (id & 7) * 16) = P.xv[i]; }
#pragma unroll
        for (int i = 0; i < 2; ++i) { const int id = lane + 64 * i; *(LAS u32x4*)(gs + (id >> 2) * 80 + (id & 3) * 16) = P.gv[i]; }
        if (ss < 7) rg_prefetch(XBR, GATE, b, chA, cho0, t0 + 256, lane, P);
        RgTile T;
        rg_tile<false>(xs, cw, Ba, Bx, ba, bx, spn, cwo, nt, lane, T);
        float TA = 1.f, TB = 0.f;
#pragma unroll
        for (int g = 0; g < 4; ++g) { TB = T.A0[g] * TB + T.B0[g]; TA *= T.A0[g]; TB = T.A1[g] * TB + T.B1[g]; TA *= T.A1[g]; }
        LAS float* tm = TM + (ss & 1) * 512;
        if (hh == 0) { tm[(wave * 32 + r) * 2] = TA; tm[(wave * 32 + r) * 2 + 1] = TB; }
        asm volatile("s_waitcnt lgkmcnt(0)" ::: "memory"); __builtin_amdgcn_s_barrier(); asm volatile("" ::: "memory");
        float cin = carry, cfull = carry;
#pragma unroll
        for (int w = 0; w < 8; ++w) { const float a = tm[(w * 32 + r) * 2], bb = tm[(w * 32 + r) * 2 + 1]; cfull = a * cfull + bb; if (w < wave) cin = cfull; }
        float cg = cin;
#pragma unroll
        for (int g = 0; g < 4; ++g) {
            const float c0 = cg, c1 = T.A0[g] * c0 + T.B0[g]; cg = T.A1[g] * c1 + T.B1[g];
            const float ci = hh ? c1 : c0;
#pragma unroll
            for (int k = 0; k < 4; ++k) { const int i = 4 * g + k; const float hv = T.hl[i] + T.ac[i] * ci; const int tl = 8 * g + 4 * hh + k;
                *(LAS bf16*)(os + tl * 80 + r * 2) = f2bf(bf2f(*(const LAS bf16*)(gs + tl * 80 + r * 2)) * hv); }
        }
        LDS_WAIT(); asm volatile("" ::: "memory");
#pragma unroll
        for (int i = 0; i < 2; ++i) { const int id = lane + 64 * i, row = id >> 2, c4 = id & 3; *(u32x4*)(HG + (size_t)(b * 2048 + t0 + row) * DM + cho0 + 8 * c4) = *(const LAS u32x4*)(os + row * 80 + c4 * 16); }
        carry = cfull;
    }
    if (wave == 0 && hh == 0) A->out[O_HP + (size_t)(j * 8 + b) * DM + cho] = carry;
}
DI void rg_sample_unit(ArgsP A, LAS unsigned char* lds, int j, int wu, int wave, int lane) {
    const int nt = wu & 1, cb = (wu >> 1) & 15, sg = wu >> 5;
    const int r = lane & 31, hh = lane >> 5, cho = cb * 64 + 32 * nt + r, chA = cb * 64;
    LAS unsigned char* xs = lds + wave * 6400;
    LAS float* cw = (LAS float*)(lds + 51200 + wave * 1280);
    const bf16* XBR = (const bf16*)(A->ws + WS_A2); const bf16* GATE = (const bf16*)(A->ws + WS_A1); bf16* HG = (bf16*)(A->ws + WS_A3);
    bf16x8 Ba[4], Bx[4]; float ba, bx, spn, cwo[5];
    rg_unit_setup(A, j, cb, nt, lane, cw, Ba, Bx, ba, bx, spn, cwo);
#pragma unroll
    for (int i = 0; i < 6; ++i) { const int id = lane + 64 * i; if (id < 352) { const int row = id >> 3, c16 = id & 7, sq = row / 11, rr = row - 11 * sq, bb = 4 * sg + sq; u32x4 v;
            if (rr < 3) { const float* cp = A->in[I_RGCONV] + ((size_t)(j * 128 + bb) * 3 + rr) * DM + chA + c16 * 8; const f32x4 f0 = *(const f32x4*)cp, f1 = *(const f32x4*)(cp + 4);
                v.x = pk2(f0[0], f0[1]); v.y = pk2(f0[2], f0[3]); v.z = pk2(f1[0], f1[1]); v.w = pk2(f1[2], f1[3]); }
            else v = *(const u32x4*)(XBR + (size_t)(MP + bb * 8 + rr - 3) * DM + chA + c16 * 8);
            *(LAS u32x4*)(xs + row * XS_PITCH + c16 * 16) = v; } }
    RgTile T;
    rg_tile<true>(xs, cw, Ba, Bx, ba, bx, spn, cwo, nt, lane, T);
#pragma unroll
    for (int g = 0; g < 4; ++g) {
        const int bb = 4 * sg + g;
        const float c0 = A->in[I_RGH][(size_t)(j * 128 + bb) * DM + cho], c1 = T.A0[g] * c0 + T.B0[g], c2 = T.A1[g] * c1 + T.B1[g];
        const float ci = hh ? c1 : c0;
#pragma unroll
        for (int k = 0; k < 4; ++k) { const int i = 4 * g + k; const float hv = T.hl[i] + T.ac[i] * ci;
            const size_t off = (size_t)(MP + bb * 8 + 4 * hh + k) * DM + cho;
            HG[off] = f2bf(bf2f(GATE[off]) * hv); }
        if (hh == 0) A->out[O_HS + (size_t)(j * 128 + bb) * DM + cho] = c2;
    }
}

#define LDS_BARRIER() do { asm volatile("s_waitcnt lgkmcnt(0)" ::: "memory"); __builtin_amdgcn_s_barrier(); asm volatile("" ::: "memory"); } while (0)
struct G2Pre { float la[16]; u32x4 kv[2], vv[4]; };
DI void g2_prefetch(const float* LAg, const bf16* QKVG, int u, int tid, G2Pre& P) {
    const int h = u & 3, row0 = (u >> 2) * 64, k = tid & 127, tq = tid >> 7;
#pragma unroll
    for (int tt = 0; tt < 16; ++tt) P.la[tt] = LAg[(size_t)(row0 + 16 * tq + tt) * 512 + h * 128 + k];
#pragma unroll
    for (int i = 0; i < 2; ++i) { const int id = tid + 512 * i, t = id >> 4, c8 = id & 15; P.kv[i] = *(const u32x4*)(QKVG + (size_t)(row0 + t) * 3072 + 512 + h * 128 + c8 * 8); }
#pragma unroll
    for (int i = 0; i < 4; ++i) { const int id = tid + 512 * i, t = id >> 5, c8 = id & 31; P.vv[i] = *(const u32x4*)(QKVG + (size_t)(row0 + t) * 3072 + 1024 + h * 256 + c8 * 8); }
}
DI void gla_g2_prompt_all(ArgsP A, LAS unsigned char* lds, int j, int ubeg, int ustep, int uend, int tid0) {
    LAS unsigned char* KE = lds; LAS unsigned char* VI = lds + 17408; LAS float* QT = (LAS float*)(lds + 51200);
    const bf16* QKVG = (const bf16*)(A->ws + WS_QKVG); const float* LAg = (const float*)(A->ws + WS_LA);
    G2Pre P;
    if (ubeg < uend) g2_prefetch(LAg, QKVG, ubeg ^ 127, tid0, P);
#pragma unroll 1
    for (int uf = ubeg; uf < uend; uf += ustep) { const int u = uf ^ 127;
        int tid = tid0; asm volatile("" : "+v"(tid));
        const int lane = tid & 63, wave = __builtin_amdgcn_readfirstlane(tid >> 6);
        const int h = u & 3, di = ((u >> 7) * 4 + h) * 32 + ((u >> 2) & 31), k = tid & 127, tq = tid >> 7;
#pragma unroll
        for (int i = 0; i < 2; ++i) { const int id = tid + 512 * i, t = id >> 4, c8 = id & 15; *(LAS u32x4*)(KE + t * K128_PITCH + c8 * 16) = P.kv[i]; }
#pragma unroll
        for (int i = 0; i < 4; ++i) { const int id = tid + 512 * i, t = id >> 5, c8 = id & 31; *(LAS u32x4*)(VI + t * KV_PITCH + c8 * 16) = P.vv[i]; }
        float bc[16]; float cum = 0.f;
#pragma unroll
        for (int tt = 0; tt < 16; ++tt) { cum += P.la[tt]; bc[tt] = cum; }
        QT[tq * 128 + k] = cum;
        LDS_BARRIER();
        if (uf + ustep < uend) g2_prefetch(LAg, QKVG, (uf + ustep) ^ 127, tid, P);
        const float q0 = QT[k], q1 = QT[128 + k], q2 = QT[256 + k], q3 = QT[384 + k];
        const float off = tq == 0 ? 0.f : (tq == 1 ? q0 : (tq == 2 ? q0 + q1 : q0 + q1 + q2)), gtot = (q0 + q1) + (q2 + q3);
#pragma unroll
        for (int tt = 0; tt < 16; ++tt) { LAS bf16* kp = (LAS bf16*)(KE + (16 * tq + tt) * K128_PITCH + k * 2); *kp = f2bf(bf2f(*kp) * fexp(gtot - (bc[tt] + off))); }
        if (tq == 0) ((float*)(A->ws + WS_GD))[(size_t)di * 128 + k] = gtot;
        LDS_BARRIER();
        const int kt = wave & 3, vt0 = (wave >> 2) * 4, r = lane & 31, hh = lane >> 5;
        f32x16 z[4];
#pragma unroll
        for (int d = 0; d < 4; ++d) z[d] = zero16();
#pragma unroll
        for (int s = 0; s < 4; ++s) { const int k0 = 16 * s + 8 * hh;
            const bf16x8 af = tr_frag(KE, K128_PITCH, k0, k0 + 4, 32 * kt, lane);
#pragma unroll
            for (int d = 0; d < 4; ++d) { const bf16x8 bv = tr_frag(VI, KV_PITCH, k0, k0 + 4, 32 * (vt0 + d), lane); z[d] = mfma32(af, bv, z[d]); } }
        bf16* DS = (bf16*)(A->ws + WS_DS) + (size_t)di * 32768;
#pragma unroll
        for (int d = 0; d < 4; ++d)
#pragma unroll
            for (int i = 0; i < 16; ++i) DS[(size_t)(32 * kt + crow(i, hh)) * 256 + 32 * (vt0 + d) + r] = f2bf(z[d][i]);
        LDS_BARRIER();
    }
}
DI void gla_sample_unit(ArgsP A, LAS unsigned char* lds, int j, int su, int tid, int wave, int lane) {
    const int b = su >> 2, h = su & 3, row0 = MP + b * 8;
    LAS float* LA = (LAS float*)lds; LAS float* QI = (LAS float*)(lds + 4096); LAS float* KI = (LAS float*)(lds + 8192); LAS float* KEND = (LAS float*)(lds + 12288);
    LAS float* EG = (LAS float*)(lds + 16384); LAS float* ATT = (LAS float*)(lds + 16896); LAS float* OP = (LAS float*)(lds + 17408);
    const bf16* QKVG = (const bf16*)(A->ws + WS_QKVG); const float* LAg = (const float*)(A->ws + WS_LA);
    const int k1 = tid & 127, tq1 = tid >> 7, vq = tid & 63, kg = tid >> 6;
    float la2[2]; bf16 qk[16]; u32x2 vw[8], gw; f32x4 s0[16];
#pragma unroll
    for (int tt = 0; tt < 2; ++tt) la2[tt] = LAg[(size_t)(row0 + 2 * tq1 + tt) * 512 + h * 128 + k1];
    if (tid < 128) {
#pragma unroll
        for (int t = 0; t < 8; ++t) { qk[2 * t] = QKVG[(size_t)(row0 + t) * 3072 + h * 128 + k1]; qk[2 * t + 1] = QKVG[(size_t)(row0 + t) * 3072 + 512 + h * 128 + k1]; } }
#pragma unroll
    for (int s = 0; s < 8; ++s) vw[s] = *(const u32x2*)(QKVG + (size_t)(row0 + s) * 3072 + 1024 + h * 256 + 4 * vq);
    gw = *(const u32x2*)(QKVG + (size_t)(row0 + (tid >> 6)) * 3072 + 2048 + h * 256 + 4 * vq);
    const float* S0 = A->in[I_GLAS] + ((size_t)((j * 128 + b) * 4 + h) * 128 + 16 * kg) * 256 + 4 * vq;
    float* SO = A->out + O_SS + ((size_t)((j * 128 + b) * 4 + h) * 128 + 16 * kg) * 256 + 4 * vq;
#pragma unroll
    for (int kk = 0; kk < 16; ++kk) s0[kk] = __builtin_nontemporal_load((const f32x4*)(S0 + (size_t)kk * 256));
#pragma unroll
    for (int tt = 0; tt < 2; ++tt) LA[(2 * tq1 + tt) * 128 + k1] = la2[tt];
    LDS_BARRIER();
    if (tid < 128) { const int k = tid; float bcv[8]; float cum = 0.f;
#pragma unroll
        for (int t = 0; t < 8; ++t) { cum += LA[t * 128 + k]; bcv[t] = cum; }
#pragma unroll
        for (int t = 0; t < 8; ++t) { const float qv = bf2f(qk[2 * t]), kv = bf2f(qk[2 * t + 1]);
            QI[t * 128 + k] = qv * fexp(bcv[t]); KI[t * 128 + k] = kv * fexp(-bcv[t]); KEND[t * 128 + k] = kv * fexp(cum - bcv[t]); }
        EG[k] = fexp(cum); }
    LDS_BARRIER();
    if (tid < 64) { const int t = tid >> 3, s = tid & 7; float a = 0.f;
        if (s <= t) { for (int k = 0; k < 128; ++k) a += QI[t * 128 + k] * KI[s * 128 + k]; }
        ATT[t * 8 + s] = a; }
    LDS_BARRIER();
    {   f32x4 v[8], o[8];
#pragma unroll
        for (int s = 0; s < 8; ++s) { v[s] = (f32x4){bf_lo(vw[s].x), bf_hi(vw[s].x), bf_lo(vw[s].y), bf_hi(vw[s].y)}; o[s] = (f32x4){0.f, 0.f, 0.f, 0.f}; }
#pragma unroll
        for (int kk = 0; kk < 16; ++kk) { const int k = 16 * kg + kk; f32x4 sn = s0[kk] * EG[k];
#pragma unroll
            for (int s = 0; s < 8; ++s) { sn += v[s] * KEND[s * 128 + k]; o[s] += s0[kk] * QI[s * 128 + k]; }
            __builtin_nontemporal_store(sn, (f32x4*)(SO + (size_t)kk * 256)); }
        if (kg == 0) {
#pragma unroll
            for (int t = 0; t < 8; ++t)
#pragma unroll
                for (int s = 0; s < 8; ++s) if (s <= t) o[t] += v[s] * ATT[t * 8 + s]; }
#pragma unroll
        for (int t = 0; t < 8; ++t) *(LAS f32x4*)(OP + (kg * 8 + t) * 256 + 4 * vq) = o[t];
    }
    LDS_BARRIER();
    {   const int t = tid >> 6;
        f32x4 o = (f32x4){0.f, 0.f, 0.f, 0.f};
#pragma unroll
        for (int kg2 = 0; kg2 < 8; ++kg2) o += *(const LAS f32x4*)(OP + (kg2 * 8 + t) * 256 + 4 * vq);
        float sq = (o[0] * o[0] + o[1] * o[1]) + (o[2] * o[2] + o[3] * o[3]); sq = wave_sum(sq);
        const float rstd = __builtin_amdgcn_rsqf(sq * (1.f / 256.f) + EPSN);
        u32x2 w; w.x = pk2(o[0] * rstd * bf_lo(gw.x), o[1] * rstd * bf_hi(gw.x)); w.y = pk2(o[2] * rstd * bf_lo(gw.y), o[3] * rstd * bf_hi(gw.y));
        *(u32x2*)((bf16*)(A->ws + WS_A3) + (size_t)(row0 + t) * DM + h * 256 + 4 * vq) = w;
    }
    LDS_BARRIER();
}
DI void gla_g3(ArgsP A, int j, int ebeg, int estep, int eend) {
    const bf16* DS = (const bf16*)(A->ws + WS_DS); bf16* SC = (bf16*)(A->ws + WS_SC); const float* GD = (const float*)(A->ws + WS_GD);
    for (int e = ebeg; e < eend; e += estep) {
        const int vq = e & 63, k = (e >> 6) & 127, bh = e >> 13;
        const size_t base = (size_t)bh * 32 * 32768 + (size_t)k * 256 + 4 * vq;
        f32x4 S = (f32x4){0.f, 0.f, 0.f, 0.f};
#pragma unroll 1
        for (int c8 = 0; c8 < 32; c8 += 8) {
            u32x2 d[8]; float g[8];
#pragma unroll
            for (int i = 0; i < 8; ++i) { d[i] = *(const u32x2*)(DS + base + (size_t)(c8 + i) * 32768); g[i] = GD[(size_t)(bh * 32 + c8 + i) * 128 + k]; }
#pragma unroll
            for (int i = 0; i < 8; ++i) { u32x2 w; w.x = pk2(S[0], S[1]); w.y = pk2(S[2], S[3]); *(u32x2*)(SC + base + (size_t)(c8 + i) * 32768) = w;
                const float eg = fexp(g[i]); S = S * eg + (f32x4){bf_lo(d[i].x), bf_hi(d[i].x), bf_lo(d[i].y), bf_hi(d[i].y)}; }
        }
        *(f32x4*)(A->out + O_SP + (size_t)(j * 32 + bh) * 32768 + (size_t)k * 256 + 4 * vq) = S;
    }
}
struct G4Pre { float la[16]; u32x4 qv[2], kv[2], vv[4], sc[8]; };
DI void g4_prefetch(const float* LAg, const bf16* QKVG, const bf16* SCg, int u, int tid, G4Pre& P) {
    const int h = u & 3, row0 = (u >> 2) * 64, di = ((u >> 7) * 4 + h) * 32 + ((u >> 2) & 31), k = tid & 127, tq = tid >> 7;
#pragma unroll
    for (int tt = 0; tt < 16; ++tt) P.la[tt] = LAg[(size_t)(row0 + 16 * tq + tt) * 512 + h * 128 + k];
#pragma unroll
    for (int i = 0; i < 2; ++i) { const int id = tid + 512 * i, t = id >> 4, c8 = id & 15; const bf16* rp = QKVG + (size_t)(row0 + t) * 3072 + h * 128 + c8 * 8; P.qv[i] = *(const u32x4*)rp; P.kv[i] = *(const u32x4*)(rp + 512); }
#pragma unroll
    for (int i = 0; i < 4; ++i) { const int id = tid + 512 * i, t = id >> 5, c8 = id & 31; P.vv[i] = *(const u32x4*)(QKVG + (size_t)(row0 + t) * 3072 + 1024 + h * 256 + c8 * 8); }
#pragma unroll
    for (int i = 0; i < 8; ++i) { const int id = tid + 512 * i; P.sc[i] = *(const u32x4*)(SCg + (size_t)di * 32768 + (size_t)id * 8); }
}
DI void gla_g4_prompt_all(ArgsP A, LAS unsigned char* lds, int j, int ubeg, int ustep, int uend, int tid0) {
    LAS unsigned char* QIm = lds; LAS unsigned char* KIm = lds + 17408; LAS unsigned char* VI = lds + 34816; LAS unsigned char* SI = lds + 68608;
    LAS float* RED = (LAS float*)(lds + 136192); LAS float* QT = (LAS float*)(lds + 137216);
    const bf16* QKVG = (const bf16*)(A->ws + WS_QKVG); const float* LAg = (const float*)(A->ws + WS_LA); const bf16* SCg = (const bf16*)(A->ws + WS_SC);
    bf16* OG = (bf16*)(A->ws + WS_A3);
    G4Pre P;
    if (ubeg < uend) g4_prefetch(LAg, QKVG, SCg, ubeg ^ 127, tid0, P);
#pragma unroll 1
    for (int uf = ubeg; uf < uend; uf += ustep) { const int u = uf ^ 127;
        int tid = tid0; asm volatile("" : "+v"(tid));
        const int lane = tid & 63, wave = __builtin_amdgcn_readfirstlane(tid >> 6);
        const int h = u & 3, row0 = (u >> 2) * 64, k = tid & 127, tq = tid >> 7;
#pragma unroll
        for (int i = 0; i < 2; ++i) { const int id = tid + 512 * i, t = id >> 4, c8 = id & 15; *(LAS u32x4*)(QIm + t * K128_PITCH + c8 * 16) = P.qv[i]; *(LAS u32x4*)(KIm + t * K128_PITCH + c8 * 16) = P.kv[i]; }
#pragma unroll
        for (int i = 0; i < 4; ++i) { const int id = tid + 512 * i, t = id >> 5, c8 = id & 31; *(LAS u32x4*)(VI + t * KV_PITCH + c8 * 16) = P.vv[i]; }
#pragma unroll
        for (int i = 0; i < 8; ++i) { const int id = tid + 512 * i, kr = id >> 5, c8 = id & 31; *(LAS u32x4*)(SI + kr * KV_PITCH + c8 * 16) = P.sc[i]; }
        float bc[16]; float cum = 0.f;
#pragma unroll
        for (int tt = 0; tt < 16; ++tt) { cum += P.la[tt]; bc[tt] = cum; }
        QT[tq * 128 + k] = cum;
        LDS_BARRIER();
        if (uf + ustep < uend) g4_prefetch(LAg, QKVG, SCg, (uf + ustep) ^ 127, tid, P);
        {   const float q0 = QT[k], q1 = QT[128 + k], q2 = QT[256 + k];
            const float off = tq == 0 ? 0.f : (tq == 1 ? q0 : (tq == 2 ? q0 + q1 : q0 + q1 + q2));
#pragma unroll
            for (int tt = 0; tt < 16; ++tt) { const float e = fexp(bc[tt] + off), ei = frcp(e);
                LAS bf16* qp = (LAS bf16*)(QIm + (16 * tq + tt) * K128_PITCH + k * 2); LAS bf16* kp = (LAS bf16*)(KIm + (16 * tq + tt) * K128_PITCH + k * 2);
                *qp = f2bf(bf2f(*qp) * e); *kp = f2bf(bf2f(*kp) * ei); }
        }
        LDS_BARRIER();
        u32x4 sgv[4];
#pragma unroll
        for (int i = 0; i < 4; ++i) { const int id = tid + 512 * i, t = id >> 5, c8 = id & 31; sgv[i] = *(const u32x4*)(QKVG + (size_t)(row0 + t) * 3072 + 2048 + h * 256 + c8 * 8); }
        const int tt2 = wave >> 2, vt0 = (wave & 3) * 2, r = lane & 31, hh = lane >> 5;
        f32x16 z[2]; z[0] = zero16(); z[1] = zero16();
#pragma unroll
        for (int st = 0; st < 2; ++st) {
            if (st <= tt2) {
                f32x16 x = zero16();
#pragma unroll
                for (int kk = 0; kk < 8; ++kk) { const bf16x8 af = *(const LAS bf16x8*)(KIm + (32 * st + r) * K128_PITCH + (16 * kk + 8 * hh) * 2), bq = *(const LAS bf16x8*)(QIm + (32 * tt2 + r) * K128_PITCH + (16 * kk + 8 * hh) * 2); x = mfma32(af, bq, x); }
                if (st == tt2) {
#pragma unroll
                    for (int i = 0; i < 16; ++i) if (crow(i, hh) > r) x[i] = 0.f; }
#pragma unroll
                for (int ss = 0; ss < 2; ++ss) { const bf16x8 pf = pack_step(x, ss, 1.0f); const int k0 = 32 * st + 16 * ss + 4 * hh;
#pragma unroll
                    for (int d = 0; d < 2; ++d) { const bf16x8 bv = tr_frag(VI, KV_PITCH, k0, k0 + 8, 32 * (vt0 + d), lane); z[d] = mfma32(pf, bv, z[d]); } }
            }
        }
#pragma unroll
        for (int kk = 0; kk < 8; ++kk) { const bf16x8 af = *(const LAS bf16x8*)(QIm + (32 * tt2 + r) * K128_PITCH + (16 * kk + 8 * hh) * 2); const int k0 = 16 * kk + 8 * hh;
#pragma unroll
            for (int d = 0; d < 2; ++d) { const bf16x8 bv = tr_frag(SI, KV_PITCH, k0, k0 + 4, 32 * (vt0 + d), lane); z[d] = mfma32(af, bv, z[d]); } }
#pragma unroll
        for (int i = 0; i < 16; ++i) { float sq = z[0][i] * z[0][i] + z[1][i] * z[1][i];
            sq = xsum16(xsum_row16(sq));
            if (r == 0) RED[(32 * tt2 + crow(i, hh)) * 4 + (wave & 3)] = sq; }
        LDS_BARRIER();
#pragma unroll
        for (int i = 0; i < 16; ++i) { const int t = 32 * tt2 + crow(i, hh); const f32x4 rq = *(const LAS f32x4*)(RED + t * 4);
            const float rstd = __builtin_amdgcn_rsqf(((rq[0] + rq[1]) + (rq[2] + rq[3])) * (1.f / 256.f) + EPSN);
#pragma unroll
            for (int d = 0; d < 2; ++d) *(LAS bf16*)(SI + t * KV_PITCH + (32 * (vt0 + d) + r) * 2) = f2bf(z[d][i] * rstd); }
        LDS_BARRIER();
#pragma unroll
        for (int i = 0; i < 4; ++i) { const int id = tid + 512 * i, t = id >> 5, c8 = id & 31; const u32x4 o = *(const LAS u32x4*)(SI + t * KV_PITCH + c8 * 16), g = sgv[i];
            u32x4 w; w.x = pk2(bf_lo(o.x) * bf_lo(g.x), bf_hi(o.x) * bf_hi(g.x)); w.y = pk2(bf_lo(o.y) * bf_lo(g.y), bf_hi(o.y) * bf_hi(g.y));
            w.z = pk2(bf_lo(o.z) * bf_lo(g.z), bf_hi(o.z) * bf_hi(g.z)); w.w = pk2(bf_lo(o.w) * bf_lo(g.w), bf_hi(o.w) * bf_hi(g.w));
            *(u32x4*)(OG + (size_t)(row0 + t) * DM + h * 256 + c8 * 8) = w; }
        LDS_BARRIER();
    }
}

#define UNIT_BEGIN int tid_u = tid; asm volatile("" : "+v"(tid_u)); const int lane_u = tid_u & 63, wave_u = __builtin_amdgcn_readfirstlane(tid_u >> 6); (void)lane_u; (void)wave_u;
#define PHASE_BEGIN ArgsP A = A0; int tid = tid0, bid = bid0; asm volatile("" : "+s"(A), "+v"(tid), "+s"(bid)); const int lane = tid & 63, wave = __builtin_amdgcn_readfirstlane(tid >> 6); \
    unsigned char* ws = A->ws; const int grp = bid & 7, rank = bid >> 3; (void)lane; (void)wave; (void)ws; (void)grp; (void)rank;
#define RS_TABLE() do { LAS float* rsl_ = (LAS float*)(lds + 131072); if (tid < 256) { const float* sp_ = (const float*)(ws + WS_SSQ) + (size_t)(256 * (8 * grp + (rank & 7)) + tid) * 32; float s_ = 0.f; \
        _Pragma("unroll") for (int q_ = 0; q_ < 8; ++q_) { const f32x4 v_ = *(const f32x4*)(sp_ + 4 * q_); s_ += (v_[0] + v_[1]) + (v_[2] + v_[3]); } rsl_[tid] = __builtin_amdgcn_rsqf(s_ * (1.f / 1024.f) + EPSN); } __syncthreads(); } while (0)
#define GRP_BAR() do { ArgsP Ab_ = A0; int bb_ = bid0; asm volatile("" : "+s"(Ab_), "+s"(bb_)); XcdBarrier gb_; gb_.bar = (unsigned*)(Ab_->ws + WS_CTL) + CW_BAR + (1 + (bb_ & 7)) * XCD_BAR_WORDS; \
    gb_.x = xb_xcc_id(); gb_.st = (volatile LAS unsigned*)(lds + MISC_OFF) + 2; grp_barrier(gb_, 32u); } while (0)
constexpr int GRID = 256;
__global__ void __launch_bounds__(NTHREADS, 2) hybrid_fwd(Args Aval) {
    extern __shared__ __attribute__((aligned(16))) unsigned char lds_raw[];
    LAS unsigned char* lds = (LAS unsigned char*)lds_raw;
    const ArgsP A0 = (ArgsP)__builtin_amdgcn_kernarg_segment_ptr();
    const int tid0 = threadIdx.x, bid0 = blockIdx.x;
    XcdBarrier bar;
    {   PHASE_BEGIN
        volatile LAS unsigned* MISC = (volatile LAS unsigned*)(lds + MISC_OFF);
        if (tid < 16) MISC[tid] = 0u;
        __syncthreads();
        bar = xcd_barrier_post((unsigned*)(ws + WS_CTL) + CW_BAR, MISC);
        (void)xcd_barrier_post((unsigned*)(ws + WS_CTL) + CW_BAR + (1 + grp) * XCD_BAR_WORDS, MISC + 2);
        p0_prologue(A, lds, (grp * 32 + rank) * NWAVES + wave, GRID * NWAVES, wave, lane);
    }
    xcd_barrier(bar);
#define PKV_PHASE(slot_) do { if ((((bid0 & 7) >> 1) & 3) == (slot_)) { PHASE_BEGIN \
        pg8::Gemm g{(const pg8::bf16_t*)(ws + WS_MN), (const pg8::bf16_t*)(ws + WS_WKV), 2048, 8192, DM}; pg8::GroupOrder S{1, 32, grp, rank}; \
        pg8::BigEpi<pg8::MemKVR8, slot_> E{{A->out + O_MK, A->out + O_MV, (pg8::bf16_t*)(ws + WS_KPB), (pg8::bf16_t*)(ws + WS_VPB), nullptr}}; \
        pg8::gemm_phase<pg8::BigEpi<pg8::MemKVR8, slot_>, pg8::GroupOrder, true, true>(lds, g, S, E, tid); } } while (0)
    PKV_PHASE(0);

#pragma unroll 1
    for (int l = 0; l < 4; ++l) {
        const int j = l >> 1;
        if ((l & 1) == 0) {
            {   PHASE_BEGIN
                const pg8::bf16_t* W = (const pg8::bf16_t*)(ws + WS_RGWIN) + (size_t)j * 2048 * DM;
                pg8::Gemm g{(const pg8::bf16_t*)(ws + WS_XB), W, MP, 2048, DM}; pg8::GroupOrder S{8, 8, grp, rank};
                pg8::BigEpi<pg8::RgInR8> E{{(pg8::bf16_t*)(ws + WS_A1), (pg8::bf16_t*)(ws + WS_A2), (const float*)(ws + WS_SSQ), A->out + O_CP + (size_t)j * 8 * 3 * DM, A->out + O_CS + (size_t)j * 128 * 3 * DM, (const LAS float*)(lds + 131072)}};
                RS_TABLE();
                pg8::gemm_phase<pg8::BigEpi<pg8::RgInR8>, pg8::GroupOrder, true, true>(lds, g, S, E, tid);
                small_gemm<2, 1, 5, 1>(lds, (const bf16*)(ws + WS_XB), W, DM, MP + 128 * grp + 64 * (rank & 1), 128 * (rank >> 1), E.e, tid, wave, lane);
            }
            GRP_BAR();
            if (l == 0) PKV_PHASE(1);
            {   PHASE_BEGIN
                { UNIT_BEGIN rg_prompt_unit(A, lds, j, grp, rank >> 1, rank & 1, wave_u, lane_u); __syncthreads(); }
                if (rank < 16) { UNIT_BEGIN const int wl = rank * 8 + wave_u; rg_sample_unit(A, lds, j, ((4 * grp + (wl >> 5)) << 5) | (wl & 31), wave_u, lane_u); }
            }
            GRP_BAR();
            if (l == 0) PKV_PHASE(2);
        } else {
            {   PHASE_BEGIN
                const pg8::bf16_t* W = (const pg8::bf16_t*)(ws + WS_GLAWIN) + (size_t)j * GINP * DM;
                pg8::Gemm g{(const pg8::bf16_t*)(ws + WS_XB), W, MP, 3072, DM}; pg8::GroupOrder S{8, 12, grp, rank, false, 8};
                pg8::BigEpi<pg8::GlaInR8> E{{(pg8::bf16_t*)(ws + WS_QKVG), (const float*)(ws + WS_SSQ), (const LAS float*)(lds + 131072)}};
                RS_TABLE();
                pg8::gemm_phase<pg8::BigEpi<pg8::GlaInR8>, pg8::GroupOrder, true, true>(lds, g, S, E, tid);
                if (rank < 24) small_gemm<2, 2, 3, 1>(lds, (const bf16*)(ws + WS_XB), W, DM, MP + 128 * grp + 64 * (rank & 1), 256 * (rank >> 1), E.e, tid, wave, lane);
                {   const int f = rank * NWAVES + wave;
                    if (f < 136) la_unit((const bf16*)(ws + WS_XB), W + (size_t)3072 * DM, (const float*)(ws + WS_SSQ), A->in[I_GLAWA2] + (size_t)j * 16 * 512, A->in[I_GLABA] + j * 512, (float*)(ws + WS_LA), (LAS float*)(lds + wave * 1024),
                                         f < 128 ? 2048 * grp + 16 * f : MP + 128 * grp + 16 * (f - 128), lane); }
            }
            GRP_BAR();
            {   PHASE_BEGIN
                if (grp & 1) { for (int su = 64 * grp + rank; su < 64 * grp + 64; su += 32) { UNIT_BEGIN gla_sample_unit(A, lds, j, su, tid_u, wave_u, lane_u); } }
                gla_g2_prompt_all(A, lds, j, 128 * grp + rank, 32, 128 * grp + 128, tid);
                if (!(grp & 1)) { for (int su = 64 * grp + rank; su < 64 * grp + 64; su += 32) { UNIT_BEGIN gla_sample_unit(A, lds, j, su, tid_u, wave_u, lane_u); } }
            }
            GRP_BAR();
            {   PHASE_BEGIN
                gla_g3(A, j, 32768 * grp + rank * NTHREADS + tid, 32 * NTHREADS, 32768 * grp + 32768);
            }
            GRP_BAR();
            {   PHASE_BEGIN
                gla_g4_prompt_all(A, lds, j, 128 * grp + rank, 32, 128 * grp + 128, tid);
            }
            GRP_BAR();
        }
        {   PHASE_BEGIN
            const pg8::bf16_t* W = (l & 1) ? (const pg8::bf16_t*)(ws + WS_GLAWOUT) + (size_t)j * DM * DM : (const pg8::bf16_t*)(ws + WS_RGWOUT) + (size_t)j * DM * DM;
            pg8::Gemm g{(const pg8::bf16_t*)(ws + WS_A3), W, MP, DM, DM}; pg8::GroupOrder S{8, 4, grp, rank};
            pg8::BigEpi<pg8::XupdR8> E{{(pg8::bf16_t*)(ws + WS_XB), (float*)(ws + WS_SSQ), 1.f}};
            pg8::gemm_phase<pg8::BigEpi<pg8::XupdR8>, pg8::GroupOrder, true, true>(lds, g, S, E, tid);
            small_gemm<1, 1, 4, 2>(lds, (const bf16*)(ws + WS_A3), W, DM, MP + 128 * grp + 64 * (rank & 1), 64 * (rank >> 1), E.e, tid, wave, lane);
        }
        GRP_BAR();
        if (l == 0) PKV_PHASE(3);
        {   PHASE_BEGIN
            const pg8::bf16_t* W = (const pg8::bf16_t*)(ws + WS_WQ) + (size_t)l * DM * DM;
            pg8::Gemm g{(const pg8::bf16_t*)(ws + WS_XB), W, MP, DM, DM}; pg8::GroupOrder S{8, 4, grp, rank};
            pg8::BigEpi<pg8::RsBf16R8<0>> E{{(pg8::bf16_t*)(ws + WS_A1), DM, (const float*)(ws + WS_SSQ), (const LAS float*)(lds + 131072)}};
            RS_TABLE();
            pg8::gemm_phase<pg8::BigEpi<pg8::RsBf16R8<0>>, pg8::GroupOrder, true, true>(lds, g, S, E, tid);
            small_gemm<1, 1, 4, 2>(lds, (const bf16*)(ws + WS_XB), W, DM, MP + 128 * grp + 64 * (rank & 1), 64 * (rank >> 1), E.e, tid, wave, lane);
            if (!(grp & 1)) attn_stage_kv(lds, (const bf16*)(ws + WS_KPB) + (size_t)l * 2048 * DM, grp, rank >> 3, tid);
        }
        GRP_BAR();
        {   PHASE_BEGIN
            if (grp & 1) { UNIT_BEGIN attn_sample_unit(lds, (const bf16*)(ws + WS_A1), A->in[I_CK] + (size_t)l * 128 * 256 * 1024, A->in[I_CV] + (size_t)l * 128 * 256 * 1024, (bf16*)(ws + WS_A2), 32 * grp + rank, tid_u, wave_u, lane_u); __syncthreads(); }
            { UNIT_BEGIN attn_prompt_unit(lds, (const bf16*)(ws + WS_A1), (const bf16*)(ws + WS_KPB) + (size_t)l * 2048 * DM, (const bf16*)(ws + WS_VPB) + (size_t)l * 2048 * DM, (bf16*)(ws + WS_A2), grp, rank >> 3, rank & 7, tid_u, wave_u, lane_u, (grp & 1) == 0); __syncthreads(); }
            if (!(grp & 1)) { UNIT_BEGIN attn_sample_unit(lds, (const bf16*)(ws + WS_A1), A->in[I_CK] + (size_t)l * 128 * 256 * 1024, A->in[I_CV] + (size_t)l * 128 * 256 * 1024, (bf16*)(ws + WS_A2), 32 * grp + rank, tid_u, wave_u, lane_u); __syncthreads(); }
        }
        GRP_BAR();
        {   PHASE_BEGIN
            const pg8::bf16_t* W = (const pg8::bf16_t*)(ws + WS_WO) + (size_t)l * DM * DM;
            pg8::Gemm g{(const pg8::bf16_t*)(ws + WS_A2), W, MP, DM, DM}; pg8::GroupOrder S{8, 4, grp, rank};
            pg8::BigEpi<pg8::XupdR8> E{{(pg8::bf16_t*)(ws + WS_XB), (float*)(ws + WS_SSQ), 1.f}};
            pg8::gemm_phase<pg8::BigEpi<pg8::XupdR8>, pg8::GroupOrder, true, true>(lds, g, S, E, tid);
            small_gemm<1, 1, 4, 2>(lds, (const bf16*)(ws + WS_A2), W, DM, MP + 128 * grp + 64 * (rank & 1), 64 * (rank >> 1), E.e, tid, wave, lane);
        }
        GRP_BAR();
        {   PHASE_BEGIN
            const pg8::bf16_t* W = (const pg8::bf16_t*)(ws + WS_W1) + (size_t)l * DFF * DM;
            pg8::Gemm g{(const pg8::bf16_t*)(ws + WS_XB), W, MP, DFF, DM}; pg8::GroupOrder S{8, 16, grp, rank, true};
            pg8::BigEpi<pg8::RsBf16R8<1>> E{{(pg8::bf16_t*)(ws + WS_H1), DFF, (const float*)(ws + WS_SSQ), (const LAS float*)(lds + 131072)}};
            RS_TABLE();
            pg8::gemm_phase<pg8::BigEpi<pg8::RsBf16R8<1>>, pg8::GroupOrder, true, true>(lds, g, S, E, tid);
            small_gemm<2, 2, 3, 1>(lds, (const bf16*)(ws + WS_XB), W, DM, MP + 128 * grp + 64 * (rank & 1), 256 * (rank >> 1), E.e, tid, wave, lane);
        }
        GRP_BAR();
        {   PHASE_BEGIN
            const pg8::bf16_t* W = (const pg8::bf16_t*)(ws + WS_W2) + (size_t)l * DM * DFF;
            pg8::Gemm g{(const pg8::bf16_t*)(ws + WS_H1), W, MP, DM, DFF}; pg8::GroupOrder S{8, 4, grp, rank};
            pg8::BigEpi<pg8::XupdR8> E{{(pg8::bf16_t*)(ws + WS_XB), (float*)(ws + WS_SSQ), 1.f}};
            pg8::gemm_phase<pg8::BigEpi<pg8::XupdR8>, pg8::GroupOrder, true, true>(lds, g, S, E, tid);
            small_gemm<1, 1, 4, 2>(lds, (const bf16*)(ws + WS_H1), W, DFF, MP + 128 * grp + 64 * (rank & 1), 64 * (rank >> 1), E.e, tid, wave, lane);
        }
        GRP_BAR();
    }
    {   PHASE_BEGIN
        const bf16* XBp = (const bf16*)(ws + WS_XB); const float* SS = (const float*)(ws + WS_SSQ);
        for (int i = rank * NWAVES + wave; i < 2048 + 128; i += 32 * NWAVES) {
            const int m = i < 2048 ? 2048 * grp + i : MP + 128 * grp + (i - 2048);
            float s = SS[(size_t)m * 32 + (lane & 31)];
            s = xsum16(xsum_row16(s));
            const float rstd = __builtin_amdgcn_rsqf(s * (1.f / 1024.f) + EPSN);
#pragma unroll
            for (int jq = 0; jq < 2; ++jq) { const u32x4 w = ((const u32x4*)(XBp + (size_t)m * DM))[64 * jq + lane]; const float* gp = A->in[I_NFIN] + 8 * (64 * jq + lane); const f32x4 g0 = *(const f32x4*)gp, g1 = *(const f32x4*)(gp + 4);
                float* op = A->out + (size_t)m * DM + 8 * (64 * jq + lane);
                __builtin_nontemporal_store((f32x4){bf_lo(w.x), bf_hi(w.x), bf_lo(w.y), bf_hi(w.y)} * rstd * g0, (f32x4*)op); __builtin_nontemporal_store((f32x4){bf_lo(w.z), bf_hi(w.z), bf_lo(w.w), bf_hi(w.w)} * rstd * g1, (f32x4*)(op + 4)); }
        }
    }
}

extern "C" void kernel_launch(void* const* d_in, const int* in_sizes, int n_in, void* d_out, int out_size, void* d_ws, size_t ws_size, hipStream_t stream) {
    static int grid = 0;
    if (grid == 0) {
        if (n_in != N_IN || (size_t)out_size != O_END || ws_size < WS_END) { fprintf(stderr, "kernel_launch: unexpected shapes (n_in %d, out %d, ws %zu); nothing launched\n", n_in, out_size, ws_size); grid = -1; return; }
        int dev = 0, cus = 0, per_cu = 0;
        if (hipGetDevice(&dev) != hipSuccess || hipDeviceGetAttribute(&cus, hipDeviceAttributeMultiprocessorCount, dev) != hipSuccess) { grid = -1; return; }
        if (hipFuncSetAttribute((const void*)hybrid_fwd, hipFuncAttributeMaxDynamicSharedMemorySize, LDS_BYTES) != hipSuccess) { fprintf(stderr, "kernel_launch: hipFuncSetAttribute failed\n"); grid = -1; return; }
        if (hipOccupancyMaxActiveBlocksPerMultiprocessor(&per_cu, (const void*)hybrid_fwd, NTHREADS, LDS_BYTES) != hipSuccess || per_cu < 1) { fprintf(stderr, "kernel_launch: occupancy query reports %d workgroups per CU\n", per_cu); }
        (void)hipGetLastError();
        if (cus < GRID) { fprintf(stderr, "kernel_launch: built for %d resident workgroups (one per CU), the device has %d CUs; nothing launched\n", GRID, cus); grid = -1; return; }
        grid = GRID;
    }
    if (grid < 0) return;
    if (hipMemsetAsync((char*)d_ws + WS_CTL, 0, CTL_ZERO_BYTES, stream) != hipSuccess) return;
    Args a{};
    for (int i = 0; i < N_IN; ++i) a.in[i] = (const float*)d_in[i];
    a.out = (float*)d_out; a.ws = (unsigned char*)d_ws;
    hipLaunchKernelGGL(hybrid_fwd, dim3(grid), dim3(NTHREADS), LDS_BYTES, stream, a);
}
```
